# Optimizing an MI355X kernel written in HIP

```python
import math
import jax, jax.numpy as jnp
from jax import lax
import numpy as np

D_MODEL = 2048
BATCH = 2
SEQ = 4096
DEPTH = 2
DEC_BATCH = 128
DEC_SEQ = 4
PAST_LEN = 8192
PAGE_SIZE = 128

N_EVEN = (DEPTH + 1) // 2
N_ODD = DEPTH // 2
WINDOW = 128
HD_A = 64
H_A = (D_MODEL // 2) // HD_A
H_A_KV = max(1, H_A // 8)
G_A = H_A // H_A_KV
W_A = H_A * HD_A
NUM_BUCKETS = 32
MAX_DISTANCE = 128
H_B = 4
DV_B = (D_MODEL // 2) // H_B
DK_B = DV_B // 2
W_B = H_B * DV_B
GLA_RANK = 16
GLA_TAU = 16.0
GLA_CHUNK = 64
H_C = 8
DK_C = D_MODEL // H_C
DV_C = 2 * DK_C
W_C = H_C * DV_C
RET_CHUNK = 128
ROPE_BASE = 10000.0
EPS = 1e-6
NEG_INF = -1e30
EVEN_SPLITS = (W_A, H_A_KV * HD_A, H_A_KV * HD_A, W_A, H_B * DK_B, H_B * DK_B, W_B, W_B, GLA_RANK)
ODD_SPLITS = (H_C * DK_C, H_C * DK_C, W_C, W_C)

kernel_name = "hybrid_swa_gla_retention_decode_step"


def rms_norm(x, g):
    xf = x.astype(jnp.float32)
    y = xf * lax.rsqrt(jnp.mean(xf * xf, axis=-1, keepdims=True) + EPS)
    return (y * g.astype(jnp.float32)).astype(x.dtype)


def split_cols(x, sizes):
    idx = [int(i) for i in np.cumsum(sizes)[:-1]]
    return jnp.split(x, idx, axis=-1)


def ada_norm(x, c, ada_w, ada_b, norm_g):
    mod = jax.nn.silu(c) @ ada_w + ada_b
    shift, scale, gate = jnp.split(mod, 3, axis=-1)
    h = rms_norm(x, norm_g) * (1 + scale[:, None]) + shift[:, None]
    return h, gate[:, None]


def t5_bucket(dist):
    dist = jnp.maximum(dist, 0)
    max_exact = NUM_BUCKETS // 2
    log_ratio = jnp.log(jnp.maximum(dist, 1).astype(jnp.float32) / max_exact) / math.log(MAX_DISTANCE / max_exact)
    large = max_exact + (log_ratio * (NUM_BUCKETS - max_exact)).astype(jnp.int32)
    large = jnp.minimum(large, NUM_BUCKETS - 1)
    return jnp.where(dist < max_exact, dist, large)


def rel_bias_for(dist, rel_bias):
    b = rel_bias[t5_bucket(dist)].astype(jnp.float32)
    return jnp.moveaxis(b, -1, 0).reshape(H_A_KV, G_A, *dist.shape)


def sink_attention(q, k, v, bias, mask, sinks):
    s = jnp.einsum('...qkgd,...skd->...kgqs', q, k).astype(jnp.float32) * HD_A ** -0.5 + bias
    s = jnp.where(mask, s, NEG_INF)
    sink = sinks.astype(jnp.float32).reshape(H_A_KV, G_A)[:, :, None, None]
    m = jnp.maximum(jnp.max(s, axis=-1, keepdims=True), sink)
    p = jnp.exp(s - m)
    denom = jnp.sum(p, axis=-1, keepdims=True) + jnp.exp(sink - m)
    return jnp.einsum('...kgqs,...skd->...qkgd', (p / denom).astype(v.dtype), v)


def swa_prompt(q, k, v, sinks, rel_bias):
    b, length = q.shape[:2]
    nb = length // WINDOW
    qb = q.reshape(b, nb, WINDOW, H_A_KV, G_A, HD_A)
    kb = k.reshape(b, nb, WINDOW, H_A_KV, HD_A)
    vb = v.reshape(b, nb, WINDOW, H_A_KV, HD_A)
    pad = ((0, 0), (1, 0), (0, 0), (0, 0), (0, 0))
    kk = jnp.concatenate([jnp.pad(kb[:, :-1], pad), kb], axis=2)
    vv = jnp.concatenate([jnp.pad(vb[:, :-1], pad), vb], axis=2)
    i = jnp.arange(WINDOW)
    s = jnp.arange(2 * WINDOW)
    dist = WINDOW + i[:, None] - s[None, :]
    kpos = (jnp.arange(nb)[:, None] - 1) * WINDOW + s[None, :]
    mask = ((dist >= 0) & (dist <= WINDOW))[None] & (kpos >= 0)[:, None, :]
    bias = rel_bias_for(dist, rel_bias)
    o = sink_attention(qb, kk, vv, bias, mask[:, None, None], sinks)
    return o.reshape(b, length, W_A)


def swa_sample(q, k, v, win_k, win_v, sinks, rel_bias):
    bd, length = q.shape[:2]
    w_buf = win_k.shape[1]
    kk = jnp.concatenate([win_k, k], axis=1)
    vv = jnp.concatenate([win_v, v], axis=1)
    qpos = PAST_LEN + jnp.arange(length)
    kpos = PAST_LEN - w_buf + jnp.arange(w_buf + length)
    dist = qpos[:, None] - kpos[None, :]
    mask = (dist >= 0) & (dist <= WINDOW)
    bias = rel_bias_for(dist, rel_bias)
    o = sink_attention(q.reshape(bd, length, H_A_KV, G_A, HD_A), kk, vv, bias, mask, sinks)
    return o.reshape(bd, length, W_A), kk[:, -w_buf:], vv[:, -w_buf:]


def pick_chunk(length, chunk):
    return chunk if length % chunk == 0 else length


def run_chunks(step, s0, xs, chunk):
    b, length = xs[0].shape[:2]
    n = length // chunk
    xs_c = tuple(jnp.moveaxis(a.reshape(b, n, chunk, *a.shape[2:]), 1, 0) for a in xs)
    s, ys = lax.scan(lambda carry, blk: step(carry, *blk), s0, xs_c)
    ys = jnp.moveaxis(ys, 0, 1)
    return ys.reshape(b, length, *ys.shape[3:]), s


def gla_step(s, q, k, v, la):
    c = q.shape[1]
    bcum = jnp.cumsum(la, axis=1)
    qt = q * jnp.exp(bcum)
    kt = k * jnp.exp(-bcum)
    causal = jnp.tril(jnp.ones((c, c), dtype=bool))
    a = jnp.where(causal, jnp.einsum('bqhd,bshd->bhqs', qt, kt), 0.0)
    o = jnp.einsum('bhqs,bshe->bqhe', a, v) + jnp.einsum('bqhd,bhde->bqhe', qt, s)
    blast = bcum[:, -1]
    k_dec = k * jnp.exp(blast[:, None] - bcum)
    s_new = jnp.exp(blast)[..., None] * s + jnp.einsum('bshd,bshe->bhde', k_dec, v)
    return s_new, o


def retention_step(s, q, k, v, log_gamma):
    c = q.shape[1]
    i = jnp.arange(c, dtype=jnp.float32)
    dist = i[:, None] - i[None, :]
    decay = jnp.where(dist >= 0, jnp.exp(jnp.maximum(dist, 0.0)[None] * log_gamma[:, None, None]), 0.0)
    a = jnp.einsum('bqhd,bshd->bhqs', q, k) * decay
    inner = jnp.exp((i + 1.0)[:, None] * log_gamma[None, :])[None, :, :, None]
    o = jnp.einsum('bhqs,bshe->bqhe', a, v) + inner * jnp.einsum('bqhd,bhde->bqhe', q, s)
    k_dec = k * jnp.exp((c - 1.0 - i)[:, None] * log_gamma[None, :])[None, :, :, None]
    s_new = jnp.exp(c * log_gamma)[None, :, None, None] * s + jnp.einsum('bshd,bshe->bhde', k_dec, v)
    return s_new, o


def rotary(x, pos):
    half = x.shape[-1] // 2
    inv = ROPE_BASE ** (-jnp.arange(half, dtype=jnp.float32) / half)
    ang = pos.astype(jnp.float32)[:, None] * inv[None, :]
    cos = jnp.cos(ang)[None, :, None]
    sin = jnp.sin(ang)[None, :, None]
    xf = x.astype(jnp.float32)
    x1, x2 = xf[..., :half], xf[..., half:]
    return jnp.concatenate([x1 * cos - x2 * sin, x2 * cos + x1 * sin], axis=-1)


def even_layer(x, c, win_k, win_v, gla_s0, rel_bias, ada_w, ada_b, norm_g, w_in, w_lr, b_lr, qn_g, kn_g, sinks, gla_g, w_out):
    b, length = x.shape[:2]
    h, gate = ada_norm(x, c, ada_w, ada_b, norm_g)
    qa, ka, va, ga, qb, kb, vb, gb, lr = split_cols(h @ w_in, EVEN_SPLITS)
    qa = rms_norm(qa.reshape(b, length, H_A, HD_A), qn_g)
    ka = rms_norm(ka.reshape(b, length, H_A_KV, HD_A), kn_g)
    va = va.reshape(b, length, H_A_KV, HD_A)
    qb = qb.reshape(b, length, H_B, DK_B).astype(jnp.float32) * DK_B ** -0.5
    kb = kb.reshape(b, length, H_B, DK_B).astype(jnp.float32)
    vb = vb.reshape(b, length, H_B, DV_B).astype(jnp.float32)
    la = (jax.nn.log_sigmoid((lr @ w_lr + b_lr).astype(jnp.float32)) / GLA_TAU).reshape(b, length, H_B, DK_B)
    if win_k is None:
        oa = swa_prompt(qa, ka, va, sinks, rel_bias)
        new_k, new_v = ka[:, -WINDOW:], va[:, -WINDOW:]
        s0 = jnp.zeros((b, H_B, DK_B, DV_B), jnp.float32)
        state_dtype = x.dtype
    else:
        oa, new_k, new_v = swa_sample(qa, ka, va, win_k, win_v, sinks, rel_bias)
        s0 = gla_s0.astype(jnp.float32)
        state_dtype = gla_s0.dtype
    ob, s_new = run_chunks(gla_step, s0, (qb, kb, vb, la), pick_chunk(length, GLA_CHUNK))
    ob = rms_norm(ob, gla_g).astype(x.dtype).reshape(b, length, W_B)
    mixed = jnp.concatenate([oa * jax.nn.silu(ga), ob * jax.nn.silu(gb)], axis=-1)
    return x + gate * (mixed @ w_out), new_k, new_v, s_new.astype(state_dtype)


def odd_layer(x, c, ret_s0, pos, ada_w, ada_b, norm_g, w_in, ret_g, w_out):
    b, length = x.shape[:2]
    h, gate = ada_norm(x, c, ada_w, ada_b, norm_g)
    q, k, v, g = split_cols(h @ w_in, ODD_SPLITS)
    q = rotary(q.reshape(b, length, H_C, DK_C), pos)
    k = rotary(k.reshape(b, length, H_C, DK_C), pos) * DK_C ** -0.5
    v = v.reshape(b, length, H_C, DV_C).astype(jnp.float32)
    log_gamma = jnp.log1p(-jnp.exp2(-5.0 - jnp.arange(H_C, dtype=jnp.float32)))
    if ret_s0 is None:
        s0 = jnp.zeros((b, H_C, DK_C, DV_C), jnp.float32)
        state_dtype = x.dtype
    else:
        s0 = ret_s0.astype(jnp.float32)
        state_dtype = ret_s0.dtype
    step = lambda s, qc, kc, vc: retention_step(s, qc, kc, vc, log_gamma)
    o, s_new = run_chunks(step, s0, (q, k, v), pick_chunk(length, RET_CHUNK))
    o = rms_norm(o, ret_g).astype(x.dtype).reshape(b, length, W_C) * jax.nn.silu(g)
    return x + gate * (o @ w_out), s_new.astype(state_dtype)


def setup_inputs(seed: int = 0) -> dict:
    key = jax.random.key(seed)
    ks = iter(jax.random.split(key, 32))

    def nrm(shape, scale=1.0):
        return jax.random.normal(next(ks), shape, jnp.float32) * scale

    def gain(shape):
        return 1.0 + nrm(shape, 0.02)

    w_buf = min(WINDOW, PAST_LEN)
    d_in_even = sum(EVEN_SPLITS)
    d_in_odd = sum(ODD_SPLITS)
    return {
        "x_prompt": nrm((BATCH, SEQ, D_MODEL)),
        "x_sample": nrm((DEC_BATCH, DEC_SEQ, D_MODEL)),
        "cache_swa_k": nrm((N_EVEN, DEC_BATCH, w_buf, H_A_KV, HD_A)),
        "cache_swa_v": nrm((N_EVEN, DEC_BATCH, w_buf, H_A_KV, HD_A)),
        "state_gla": nrm((N_EVEN, DEC_BATCH, H_B, DK_B, DV_B), 0.5),
        "state_ret": nrm((N_ODD, DEC_BATCH, H_C, DK_C, DV_C), 0.5),
        "c_prompt": nrm((BATCH, D_MODEL)),
        "c_sample": nrm((DEC_BATCH, D_MODEL)),
        "rel_bias": nrm((NUM_BUCKETS, H_A), 0.5),
        "ada_w_even": nrm((N_EVEN, D_MODEL, 3 * D_MODEL), 0.5 * D_MODEL ** -0.5),
        "ada_b_even": nrm((N_EVEN, 3 * D_MODEL), 0.02),
        "norm_g_even": gain((N_EVEN, D_MODEL)),
        "w_in_even": nrm((N_EVEN, D_MODEL, d_in_even), D_MODEL ** -0.5),
        "w_lr_even": nrm((N_EVEN, GLA_RANK, H_B * DK_B), GLA_RANK ** -0.5),
        "b_lr_even": nrm((N_EVEN, H_B * DK_B), 0.02),
        "qn_g_even": gain((N_EVEN, HD_A)),
        "kn_g_even": gain((N_EVEN, HD_A)),
        "sinks_even": nrm((N_EVEN, H_A), 0.5),
        "gla_g_even": gain((N_EVEN, DV_B)),
        "w_out_even": nrm((N_EVEN, W_A + W_B, D_MODEL), (W_A + W_B) ** -0.5),
        "ada_w_odd": nrm((N_ODD, D_MODEL, 3 * D_MODEL), 0.5 * D_MODEL ** -0.5),
        "ada_b_odd": nrm((N_ODD, 3 * D_MODEL), 0.02),
        "norm_g_odd": gain((N_ODD, D_MODEL)),
        "w_in_odd": nrm((N_ODD, D_MODEL, d_in_odd), D_MODEL ** -0.5),
        "ret_g_odd": gain((N_ODD, DV_C)),
        "w_out_odd": nrm((N_ODD, W_C, D_MODEL), W_C ** -0.5),
    }


def reference(x_prompt, x_sample, cache_swa_k, cache_swa_v, state_gla, state_ret, c_prompt, c_sample, rel_bias,
              ada_w_even, ada_b_even, norm_g_even, w_in_even, w_lr_even, b_lr_even, qn_g_even, kn_g_even,
              sinks_even, gla_g_even, w_out_even, ada_w_odd, ada_b_odd, norm_g_odd, w_in_odd, ret_g_odd, w_out_odd):
    pos_prompt = jnp.arange(x_prompt.shape[1])
    pos_sample = PAST_LEN + jnp.arange(x_sample.shape[1])
    y_prompt, y_sample = x_prompt, x_sample
    swa_k_p, swa_v_p, gla_p, ret_p = [], [], [], []
    swa_k_s, swa_v_s, gla_s, ret_s = [], [], [], []
    for layer in range(DEPTH):
        j = layer // 2
        if layer % 2 == 0:
            ew = (ada_w_even[j], ada_b_even[j], norm_g_even[j], w_in_even[j], w_lr_even[j], b_lr_even[j],
                  qn_g_even[j], kn_g_even[j], sinks_even[j], gla_g_even[j], w_out_even[j])
            y_prompt, kp, vp, sp = even_layer(y_prompt, c_prompt, None, None, None, rel_bias, *ew)
            y_sample, ksm, vsm, ssm = even_layer(y_sample, c_sample, cache_swa_k[j], cache_swa_v[j], state_gla[j], rel_bias, *ew)
            swa_k_p.append(kp); swa_v_p.append(vp); gla_p.append(sp)
            swa_k_s.append(ksm); swa_v_s.append(vsm); gla_s.append(ssm)
        else:
            ow = (ada_w_odd[j], ada_b_odd[j], norm_g_odd[j], w_in_odd[j], ret_g_odd[j], w_out_odd[j])
            y_prompt, rp = odd_layer(y_prompt, c_prompt, None, pos_prompt, *ow)
            y_sample, rsm = odd_layer(y_sample, c_sample, state_ret[j], pos_sample, *ow)
            ret_p.append(rp); ret_s.append(rsm)
    return (y_prompt, y_sample, jnp.stack(swa_k_p), jnp.stack(swa_v_p), jnp.stack(gla_p), jnp.stack(ret_p),
            jnp.stack(swa_k_s), jnp.stack(swa_v_s), jnp.stack(gla_s), jnp.stack(ret_s))
```

```cpp
#include <hip/hip_runtime.h>
#include <cstdio>
#include <cstdint>

#define LAS __attribute__((address_space(3)))
#define GAS __attribute__((address_space(1)))
typedef unsigned short bf16_t;
typedef short bf16x8 __attribute__((ext_vector_type(8)));
typedef short s16x4 __attribute__((ext_vector_type(4)));
typedef float f32x4 __attribute__((ext_vector_type(4)));
typedef float f32x2 __attribute__((ext_vector_type(2)));
typedef unsigned u32x4 __attribute__((ext_vector_type(4)));
typedef unsigned u32x2 __attribute__((ext_vector_type(2)));

namespace pg8 {
constexpr int BM = 256, BK = 64, HALF = 128, HTB = HALF * BK * 2  , STAGE_BYTES = 8 * HTB, NXCD = 8, WGM = 8;

__host__ __device__ __forceinline__ int lds_byte(int r, int c) { const int st = (r >> 4) * 2 + (c >> 5), rr = r & 15, cc = c & 31, ob = rr * 64 + cc * 2; return st * 1024 + (ob ^ (((ob >> 9) & 1) << 5)); }
__host__ __device__ __forceinline__ void stage_rc(int b, int& R, int& C) { const int st = b / 1024, sb = b % 1024, swz = sb ^ (((sb >> 9) & 1) << 5); R = (st >> 1) * 16 + swz / 64; C = (st & 1) * 32 + (swz % 64) / 2; }
__host__ __device__ __forceinline__ int perm32(int rho) { const int n = rho >> 4, i = rho & 15; return 8 * (i >> 2) + 4 * n + (i & 3); }

struct Unit { int pm, pn; };
struct Gemm { const bf16_t* A; const bf16_t* Bt; int M, N, K; };

struct StaticOrder {
    int nM, nN, nwg, G, c;
    __host__ __device__ void init(int M, int N, int G_, int c_) { nM = M / BM; nN = N / BM; nwg = nM * nN; G = G_; c = c_; }
    __host__ __device__ bool next(int i, Unit& u) const {
        const long L = (long)i * G + c; if (L >= nwg) return false;
        int wgid = (int)L; { const int q = nwg / NXCD, r = nwg % NXCD, xcd = wgid % NXCD, off = wgid / NXCD; wgid = (xcd < r ? xcd * (q + 1) : r * (q + 1) + (xcd - r) * q) + off; }
        const int nig = WGM * nN, gid = wgid / nig, fm = gid * WGM, gsz = (nM - fm) < WGM ? (nM - fm) : WGM;
        u.pm = fm + ((wgid % nig) % gsz); u.pn = (wgid % nig) / gsz; return true;
    }
    __device__ __forceinline__ void a_ready(const Unit&) const {}
    __device__ __forceinline__ void done(const Unit&) const {}
};

__device__ __forceinline__ unsigned cvt_pk_bf16(float lo, float hi) { unsigned r; asm volatile("v_cvt_pk_bf16_f32 %0, %1, %2" : "=v"(r) : "v"(lo), "v"(hi)); return r; }

template <class Epi, class Sched, bool ALIGN_EPI = false, bool SP2 = false>
__device__ __forceinline__ void gemm_phase(LAS unsigned char* lds, const Gemm g, const Sched& S, const Epi& E) {
    const int tid = threadIdx.x, wid = __builtin_amdgcn_readfirstlane(tid >> 6), lane = tid & 63, wr = wid >> 2, wc = wid & 3, fr = lane & 15, fq = lane >> 4;
    const int K = g.K, nt = K / BK;
    unsigned voffA[2], voffB[2];
#pragma unroll
    for (int i = 0; i < 2; ++i) { int R, C; stage_rc(tid * 16 + i * 8192, R, C); const int Rb = Epi::PERM ? ((R & ~31) + perm32(R & 31)) : R;
        voffA[i] = (unsigned)(R * K + C) * 2u; voffB[i] = (unsigned)(Rb * K + C) * 2u; }
    const size_t kstep = (size_t)(BK * 2);
    const size_t hstep = (size_t)HALF * K * 2;
    const size_t tstep = 2 * hstep;
    const unsigned ldsw = (unsigned)wid * 1024u;
    const int aoff = lds_byte(wr * 64 + fr, fq * 8), boff = lds_byte(wc * 32 + fr, fq * 8);
#define PG8_SA(b, h) (((b) * 2 + (h)) * HTB)
#define PG8_SB(b, h) ((4 + (b) * 2 + (h)) * HTB)
#define PG8_STAGE(bufoff, gbase, voff) do { _Pragma("unroll") for (int _i = 0; _i < 2; ++_i) \
        __builtin_amdgcn_global_load_lds((const unsigned*)((const char*)(gbase) + (voff)[_i]), (LAS unsigned*)(lds + (bufoff) + ldsw + _i * 8192), 16, 0, 0); } while (0)
#define PG8_LDA(dst, b, h) do { _Pragma("unroll") for (int m = 0; m < 4; ++m) _Pragma("unroll") for (int k = 0; k < 2; ++k) dst[m][k] = *(const LAS bf16x8*)(lds + PG8_SA(b, h) + aoff + m * 2048 + k * 1024); } while (0)
#define PG8_LDB(dst, b, h) do { _Pragma("unroll") for (int n = 0; n < 2; ++n) _Pragma("unroll") for (int k = 0; k < 2; ++k) dst[n][k] = *(const LAS bf16x8*)(lds + PG8_SB(b, h) + boff + n * 2048 + k * 1024); } while (0)
#define PG8_MMA(ai, bj, At, Bt) do { __builtin_amdgcn_s_setprio(1); _Pragma("unroll") for (int m = 0; m < 4; ++m) _Pragma("unroll") for (int n = 0; n < 2; ++n) _Pragma("unroll") for (int k = 0; k < 2; ++k) \
        acc[ai][bj][m][n] = __builtin_amdgcn_mfma_f32_16x16x32_bf16(Bt[n][k], At[m][k], acc[ai][bj][m][n], 0, 0, 0); __builtin_amdgcn_s_setprio(0); } while (0)
#define PG8_WAIT_V(n) asm volatile("s_waitcnt vmcnt(" #n ")" ::: "memory")
#define PG8_WAIT_L(n) asm volatile("s_waitcnt lgkmcnt(" #n ")" ::: "memory")
#define PG8_BAR __builtin_amdgcn_s_barrier()
#define PG8_SCHED __builtin_amdgcn_sched_barrier(0)
    Unit cur, nxt; int ui = 0;
    if (!S.next(0, cur)) return;
    f32x4 acc[2][2][4][2];
#pragma unroll
    for (int a = 0; a < 2; ++a)
#pragma unroll
        for (int b = 0; b < 2; ++b)
#pragma unroll
            for (int m = 0; m < 4; ++m)
#pragma unroll
                for (int n = 0; n < 2; ++n) acc[a][b][m][n] = (f32x4){0.f, 0.f, 0.f, 0.f};
    bf16x8 At[4][2], B0[2][2], B1[2][2];
    const char* cA = (const char*)g.A + (size_t)cur.pm * tstep; const char* cB = (const char*)g.Bt + (size_t)cur.pn * tstep;
    S.a_ready(cur);
    if constexpr (SP2) {
        PG8_STAGE(PG8_SB(0, 0), cB, voffB); PG8_STAGE(PG8_SB(0, 1), cB + hstep, voffB); PG8_STAGE(PG8_SA(0, 0), cA, voffA); PG8_STAGE(PG8_SA(0, 1), cA + hstep, voffA);
        if (wr == 1) PG8_BAR;
        PG8_WAIT_V(2); PG8_BAR;
        PG8_STAGE(PG8_SB(1, 0), cB + kstep, voffB); PG8_STAGE(PG8_SA(1, 0), cA + kstep, voffA); PG8_STAGE(PG8_SB(1, 1), cB + hstep + kstep, voffB);
        PG8_WAIT_V(6); PG8_BAR;
    } else {
        PG8_STAGE(PG8_SB(0, 0), cB, voffB); PG8_STAGE(PG8_SA(0, 0), cA, voffA); PG8_STAGE(PG8_SB(0, 1), cB + hstep, voffB); PG8_STAGE(PG8_SA(0, 1), cA + hstep, voffA);
        if (wr == 1) PG8_BAR;
        PG8_WAIT_V(4); PG8_BAR;
        PG8_STAGE(PG8_SB(1, 0), cB + kstep, voffB); PG8_STAGE(PG8_SA(1, 0), cA + kstep, voffA); PG8_STAGE(PG8_SB(1, 1), cB + hstep + kstep, voffB);
        PG8_WAIT_V(6); PG8_BAR;
    }
    for (;;) {
        const bool has_next = S.next(ui + 1, nxt);
        const char* nA = has_next ? (const char*)g.A + (size_t)nxt.pm * tstep : cA; const char* nB = has_next ? (const char*)g.Bt + (size_t)nxt.pn * tstep : cB;
        for (int t = 0; t < nt; t += 2) {
            const bool last = (t == nt - 2);
            const char* a1 = cA + (size_t)(t + 1) * kstep;
            const char* a2 = last ? nA : cA + (size_t)(t + 2) * kstep; const char* b2 = last ? nB : cB + (size_t)(t + 2) * kstep;
            const char* a3 = a2 + kstep; const char* b3 = b2 + kstep;
            if (last && has_next) S.a_ready(nxt);
            if constexpr (SP2) {
            PG8_LDB(B0, 0, 0); PG8_LDB(B1, 0, 1); PG8_SCHED; PG8_LDA(At, 0, 0); PG8_STAGE(PG8_SA(1, 1), a1 + hstep, voffA);
            PG8_WAIT_V(8); PG8_WAIT_L(0); PG8_BAR; PG8_MMA(0, 0, At, B0); PG8_MMA(0, 1, At, B1); PG8_BAR; PG8_SCHED;
            PG8_LDA(At, 0, 1); PG8_STAGE(PG8_SB(0, 0), b2, voffB); PG8_STAGE(PG8_SB(0, 1), b2 + hstep, voffB); PG8_STAGE(PG8_SA(0, 0), a2, voffA);
            PG8_WAIT_V(8); PG8_WAIT_L(0); PG8_BAR; PG8_MMA(1, 0, At, B0); PG8_MMA(1, 1, At, B1); PG8_BAR; PG8_SCHED;
            PG8_LDB(B0, 1, 0); PG8_LDB(B1, 1, 1); PG8_SCHED; PG8_LDA(At, 1, 0); PG8_STAGE(PG8_SA(0, 1), a2 + hstep, voffA);
            PG8_WAIT_V(8); PG8_WAIT_L(0); PG8_BAR; PG8_MMA(0, 0, At, B0); PG8_MMA(0, 1, At, B1); PG8_BAR; PG8_SCHED;
            PG8_LDA(At, 1, 1); PG8_STAGE(PG8_SB(1, 0), b3, voffB); PG8_STAGE(PG8_SB(1, 1), b3 + hstep, voffB); PG8_STAGE(PG8_SA(1, 0), a3, voffA);
            PG8_WAIT_V(8); PG8_WAIT_L(0); PG8_BAR; PG8_MMA(1, 0, At, B0); PG8_MMA(1, 1, At, B1); PG8_BAR; PG8_SCHED;
            } else {
            PG8_LDB(B0, 0, 0); PG8_SCHED; PG8_LDA(At, 0, 0); PG8_STAGE(PG8_SA(1, 1), a1 + hstep, voffA);
            PG8_WAIT_L(8); PG8_BAR; PG8_WAIT_L(0); PG8_MMA(0, 0, At, B0); PG8_BAR; PG8_SCHED;
            PG8_LDB(B1, 0, 1); PG8_STAGE(PG8_SB(0, 0), b2, voffB);
            PG8_BAR; PG8_WAIT_L(0); PG8_MMA(0, 1, At, B1); PG8_BAR;
            PG8_LDA(At, 0, 1); PG8_STAGE(PG8_SA(0, 0), a2, voffA);
            PG8_BAR; PG8_WAIT_L(0); PG8_MMA(1, 0, At, B0); PG8_BAR; PG8_SCHED;
            PG8_STAGE(PG8_SB(0, 1), b2 + hstep, voffB);
            PG8_WAIT_V(6); PG8_BAR; PG8_MMA(1, 1, At, B1); PG8_BAR;
            PG8_LDB(B0, 1, 0); PG8_SCHED; PG8_LDA(At, 1, 0); PG8_STAGE(PG8_SA(0, 1), a2 + hstep, voffA);
            PG8_WAIT_L(8); PG8_BAR; PG8_WAIT_L(0); PG8_MMA(0, 0, At, B0); PG8_BAR; PG8_SCHED;
            PG8_LDB(B1, 1, 1); PG8_STAGE(PG8_SB(1, 0), b3, voffB);
            PG8_BAR; PG8_WAIT_L(0); PG8_MMA(0, 1, At, B1); PG8_BAR;
            PG8_LDA(At, 1, 1); PG8_STAGE(PG8_SA(1, 0), a3, voffA);
            PG8_BAR; PG8_WAIT_L(0); PG8_MMA(1, 0, At, B0); PG8_BAR; PG8_SCHED;
            PG8_STAGE(PG8_SB(1, 1), b3 + hstep, voffB);
            PG8_WAIT_V(6); PG8_BAR; PG8_MMA(1, 1, At, B1); PG8_BAR;
            }
        }
        if constexpr (ALIGN_EPI) { if (wr == 0) PG8_BAR; }
        E(acc, cur, wr, wc, fr, fq); S.done(cur);
        if (!has_next) break;
#pragma unroll
        for (int a = 0; a < 2; ++a)
#pragma unroll
            for (int b = 0; b < 2; ++b)
#pragma unroll
                for (int m = 0; m < 4; ++m)
#pragma unroll
                    for (int n = 0; n < 2; ++n) acc[a][b][m][n] = (f32x4){0.f, 0.f, 0.f, 0.f};
        cur = nxt; cA = nA; cB = nB; ++ui;
        if constexpr (ALIGN_EPI) { if (wr == 1) PG8_BAR; }
    }
    PG8_WAIT_V(0);
    if constexpr (!ALIGN_EPI) { if (wr == 0) PG8_BAR; }
    PG8_BAR;
#undef PG8_SA
#undef PG8_SB
#undef PG8_STAGE
#undef PG8_LDA
#undef PG8_LDB
#undef PG8_MMA
#undef PG8_WAIT_V
#undef PG8_WAIT_L
#undef PG8_BAR
#undef PG8_SCHED
}
}

constexpr int NWAVES = 8, NTHREADS = 512;
constexpr int DM = 2048, SEQ = 4096, TP = 8192, TS = 512, MROWS = TP + TS;
constexpr int NBD = 128;
constexpr int N1 = 5376, N1P = 5632, NIN0 = 5392, N3 = 12288, KO1 = 4096;
constexpr int C_QA = 0, C_KA = 1024, C_VA = 1152, C_GA = 1280, C_QB = 2304, C_KB = 2816, C_VB = 3328, C_GB = 4352;
constexpr int C_Q = 0, C_K = 2048, C_V = 4096, C_G = 8192;
constexpr float EPS = 1e-6f;
enum { I_XP = 0, I_XS, I_CK, I_CV, I_SG, I_SR, I_CP, I_CS, I_RB, I_AWE, I_ABE, I_NGE, I_WIE, I_WLR, I_BLR, I_QNG, I_KNG, I_SNK, I_GLG, I_WOE, I_AWO, I_ABO, I_NGO, I_WIO, I_RTG, I_WOO, N_IN };
constexpr size_t O_Y = 0, O_KP = 17825792, O_VP = 17858560, O_GP = 17891328, O_RP = 18153472, O_KS = 20250624, O_VS = 22347776, O_GS = 24444928, O_RS = 41222144, O_END = 175439872;

constexpr size_t MiB = 1u << 20;
constexpr size_t WS_CTL = 0, CTL_ZERO_BYTES = 65536;
constexpr size_t WS_SC = 1 * MiB, WS_MOD0 = 2 * MiB, WS_MOD1 = 6 * MiB, WS_ROT = 10 * MiB, WS_LR = 15 * MiB;
constexpr size_t WS_WT1 = 16 * MiB, WS_WT2 = 38 * MiB, WS_WT3 = 46 * MiB, WS_WT4 = 94 * MiB;
constexpr size_t WS_H = 110 * MiB, WS_P0 = 144 * MiB, WS_MIX = 234 * MiB, WS_Y1 = 268 * MiB, WS_P1 = 336 * MiB, WS_RO = 540 * MiB, WS_SPG = 608 * MiB, WS_SPR = 640 * MiB, WS_END = 768 * MiB;
constexpr int CW_BAR = 1024;
constexpr int CW_Q0 = 8192;

constexpr int LDS_MISC = 0;
constexpr int LDS_SCR = 256;
constexpr int LDS_BYTES = 147456;
constexpr int LDS_SCR_BYTES = LDS_BYTES - LDS_SCR;

#define LDS_WAIT() asm volatile("s_waitcnt lgkmcnt(0)" ::: "memory")
#define VM_WAIT() asm volatile("s_waitcnt vmcnt(0)" ::: "memory")
typedef __bf16 bf16n2 __attribute__((ext_vector_type(2)));
__device__ __forceinline__ unsigned f2bf_hw(float f) { return (unsigned)__builtin_bit_cast(unsigned short, (__bf16)f); }
__device__ __forceinline__ unsigned pk2_hw(float lo, float hi) { const f32x2 v = {lo, hi}; return __builtin_bit_cast(unsigned, __builtin_convertvector(v, bf16n2)); }
__device__ __forceinline__ unsigned f2bf(float f) { unsigned u = __builtin_bit_cast(unsigned, f); return (u + 0x7fffu + ((u >> 16) & 1u)) >> 16; }
__device__ __forceinline__ unsigned pk2(float lo, float hi) { return f2bf(lo) | (f2bf(hi) << 16); }
__device__ __forceinline__ float bf2f(bf16_t b) { return __builtin_bit_cast(float, (unsigned)b << 16); }
__device__ __forceinline__ float bflo(unsigned w) { return __builtin_bit_cast(float, w << 16); }
__device__ __forceinline__ float bfhi(unsigned w) { return __builtin_bit_cast(float, w & 0xffff0000u); }
__device__ __forceinline__ float silu_f(float x) { return x * __builtin_amdgcn_rcpf(1.f + __expf(-x)); }
__device__ __forceinline__ float logsig_f(float z) { return fminf(z, 0.f) - __logf(1.f + __expf(-fabsf(z))); }
__device__ __forceinline__ float wave_sum(float v) {
#pragma unroll
    for (int o = 1; o < 64; o <<= 1) v += __shfl_xor(v, o);
    return v;
}
__device__ __forceinline__ float wave_incl_scan(float v) {
#define WIS_DPP(x, ctrl, rmask) __builtin_bit_cast(float, __builtin_amdgcn_update_dpp(0, __builtin_bit_cast(int, (x)), (ctrl), (rmask), 0xf, false))
    v += WIS_DPP(v, 0x111, 0xf);
    v += WIS_DPP(v, 0x112, 0xf);
    v += WIS_DPP(v, 0x114, 0xf);
    v += WIS_DPP(v, 0x118, 0xf);
    v += WIS_DPP(v, 0x142, 0xa);
    v += WIS_DPP(v, 0x143, 0xc);
#undef WIS_DPP
    return v;
}
__device__ __forceinline__ float red16_sum(float v) { v += __shfl_xor(v, 1); v += __shfl_xor(v, 2); v += __shfl_xor(v, 4); v += __shfl_xor(v, 8); return v; }
__device__ __forceinline__ float red16_max(float v) { v = fmaxf(v, __shfl_xor(v, 1)); v = fmaxf(v, __shfl_xor(v, 2)); v = fmaxf(v, __shfl_xor(v, 4)); v = fmaxf(v, __shfl_xor(v, 8)); return v; }

__device__ __forceinline__ bf16x8 frag_nat(const LAS bf16_t* base, int pitch, int x0, int k0, int lane) {
    return *(const LAS bf16x8*)(base + (x0 + (lane & 15)) * pitch + k0 + 8 * (lane >> 4));
}
__device__ __forceinline__ bf16x8 frag_tr(const LAS bf16_t* base, int pitch, int x0, int k0, int lane) {
    const int g = lane >> 4, i = lane & 15;
    const LAS bf16_t* p = base + (k0 + 8 * g + (i >> 2)) * pitch + x0 + 4 * (i & 3);
    const s16x4 lo = __builtin_amdgcn_ds_read_tr16_b64_v4i16((LAS s16x4*)p);
    const s16x4 hi = __builtin_amdgcn_ds_read_tr16_b64_v4i16((LAS s16x4*)(p + 4 * pitch));
    return (bf16x8){lo[0], lo[1], lo[2], lo[3], hi[0], hi[1], hi[2], hi[3]};
}
#define MFMA16(a, b, c) __builtin_amdgcn_mfma_f32_16x16x32_bf16((a), (b), (c), 0, 0, 0)

#define XB_TMO      128
#define XB_XCNT(j)  (256  + 64 * (j))
#define XB_XSUB(j)  (1280 + 64 * (j))
#define XB_XGEN(j)  (2304 + 64 * (j))
#define XB_TOP      3328
#define XB_TOPGEN   3392
#define XCD_BAR_WORDS 3456
#define XB_SPIN_CAP (1u << 20)
__device__ __forceinline__ unsigned xb_ld(unsigned* p)              { return __hip_atomic_load(p, __ATOMIC_RELAXED, __HIP_MEMORY_SCOPE_AGENT); }
__device__ __forceinline__ unsigned xb_add(unsigned* p, unsigned v) { return __hip_atomic_fetch_add(p, v, __ATOMIC_RELAXED, __HIP_MEMORY_SCOPE_AGENT); }
__device__ __forceinline__ unsigned xb_xcc_id() { return (unsigned)__builtin_amdgcn_s_getreg((3 << 11) | 20) & 0xFu; }
#define XB_SPIN(cond, bar) do { unsigned _sp = 0; while (cond) { __builtin_amdgcn_s_sleep(1); \
    if ((++_sp & 255u) == 0u) { if (xb_ld(&(bar)[XB_TMO])) break; if (_sp > XB_SPIN_CAP) { atomicAdd(&(bar)[XB_TMO], 1u); break; } } } } while (0)
struct XcdBarrier { unsigned* bar; unsigned x; volatile LAS unsigned* st; };
__device__ __forceinline__ XcdBarrier xcd_barrier_post(unsigned* bar, volatile LAS unsigned* st) {
    XcdBarrier b; b.bar = bar; b.x = xb_xcc_id(); b.st = st;
    if (threadIdx.x == 0) (void)xb_add(&bar[XB_XCNT(b.x)], 1u);
    return b;
}
__device__ __forceinline__ void xcd_barrier_complete(unsigned* bar, unsigned x, unsigned& nloc, unsigned& nx) {
    const unsigned G = gridDim.x * gridDim.y * gridDim.z;
    unsigned sum, cnt, mine, sp = 0u;
    for (;;) {
        sum = 0u; cnt = 0u; mine = 0u;
#pragma unroll
        for (unsigned j = 0; j < 16; ++j) { const unsigned c = xb_ld(&bar[XB_XCNT(j)]); sum += c; cnt += (c > 0u) ? 1u : 0u; mine = (j == x) ? c : mine; }
        if (sum == G) break;
        __builtin_amdgcn_s_sleep(1);
        if ((++sp & 255u) == 0u) { if (xb_ld(&bar[XB_TMO])) break; if (sp > XB_SPIN_CAP) { atomicAdd(&bar[XB_TMO], 1u); break; } }
    }
    nloc = mine > 0u ? mine : 1u; nx = cnt > 0u ? cnt : 1u;
}
__device__ __forceinline__ void xcd_barrier(const XcdBarrier& b) {
    asm volatile("s_waitcnt vmcnt(0)" ::: "memory");
    __syncthreads();
    if (threadIdx.x == 0) {
        unsigned* bar = b.bar;
        __builtin_amdgcn_s_waitcnt(0);
        unsigned nloc = b.st[0], nx = b.st[1];
        if (nloc == 0u) { xcd_barrier_complete(bar, b.x, nloc, nx); b.st[0] = nloc; b.st[1] = nx; }
        const unsigned old = xb_add(&bar[XB_XSUB(b.x)], 1u);
        const unsigned gen = old / nloc;
        if (old + 1u == (gen + 1u) * nloc) {
            __builtin_amdgcn_fence(__ATOMIC_RELEASE, "agent");
            asm volatile("s_waitcnt vmcnt(0)" ::: "memory");
            const unsigned og = xb_add(&bar[XB_TOP], 1u);
            const unsigned tg = og / nx;
            if (og + 1u == (tg + 1u) * nx) xb_add(&bar[XB_TOPGEN], 1u);
            else XB_SPIN(xb_ld(&bar[XB_TOPGEN]) == tg, bar);
            __builtin_amdgcn_fence(__ATOMIC_ACQUIRE, "agent");
            xb_add(&bar[XB_XGEN(b.x)], 1u);
            asm volatile("s_waitcnt vmcnt(0)" ::: "memory");
        } else {
            XB_SPIN(xb_ld(&bar[XB_XGEN(b.x)]) == gen, bar);
            __builtin_amdgcn_fence(__ATOMIC_ACQUIRE, "agent");
            asm volatile("s_waitcnt vmcnt(0)" ::: "memory");
        }
    }
    __syncthreads();
}

struct Args { const float* in[N_IN]; float* out; unsigned char* ws; int ph_lo, ph_hi; };
struct Frame {
    LAS unsigned char* lds;
    volatile LAS unsigned* MISC;
    int tid, lane, wave, G;
};
__device__ __forceinline__ int next_item(const Frame& F, unsigned* head) {
    __syncthreads();
    if (F.tid == 0) F.MISC[4] = __hip_atomic_fetch_add(head, 1u, __ATOMIC_RELAXED, __HIP_MEMORY_SCOPE_AGENT);
    __syncthreads();
    return (int)F.MISC[4];
}

struct TrItem { const float* src; bf16_t* dst; int ldw, K; bool ok; };
__device__ __forceinline__ TrItem tr_desc(const float* W, int K, int ldw, int ncol_valid, bf16_t* WT, int kb, int nb, int lane) {
    const int k0 = 64 * kb, n0 = 64 * nb, n4 = n0 + 4 * (lane & 15);
    TrItem d; d.src = W + (size_t)(k0 + (lane >> 4)) * ldw + (n4 < ncol_valid ? n4 : 0)  ; d.dst = WT + (size_t)(n0 + (lane >> 3)) * K + k0 + 8 * (lane & 7); d.ldw = ldw; d.K = K; d.ok = n4 < ncol_valid; return d;
}
__device__ __forceinline__ void tr_load(const TrItem& d, f32x4 (&v)[16]) {
#pragma unroll
    for (int i = 0; i < 16; ++i) v[i] = __builtin_nontemporal_load((const f32x4*)(d.src + (size_t)(4 * i) * d.ldw));
}
__device__ __forceinline__ void tr_finish(const TrItem& d, const f32x4 (&v)[16], LAS float* scr, int lane) {
    const int kr = lane >> 4;
    const float keep = d.ok ? 1.f : 0.f;
#pragma unroll
    for (int i = 0; i < 16; ++i) { LAS float* t = scr + (kr + 4 * i) * 65 + 4 * (lane & 15); t[0] = v[i].x * keep; t[1] = v[i].y * keep; t[2] = v[i].z * keep; t[3] = v[i].w * keep; }
    LDS_WAIT(); asm volatile("" ::: "memory");
    const int c = lane & 7;
#pragma unroll
    for (int j = 0; j < 8; ++j) { const int n = (lane >> 3) + 8 * j; const LAS float* s = scr + (8 * c) * 65 + n;
        u32x4 o; o.x = pk2_hw(s[0 * 65], s[1 * 65]); o.y = pk2_hw(s[2 * 65], s[3 * 65]); o.z = pk2_hw(s[4 * 65], s[5 * 65]); o.w = pk2_hw(s[6 * 65], s[7 * 65]);
        *(u32x4*)(d.dst + (size_t)(8 * j) * d.K) = o; }
    LDS_WAIT(); asm volatile("" ::: "memory");
}
__device__ __forceinline__ TrItem p0_tr_desc(const Args& A, int it, int lane) {
    constexpr int I1 = 32 * 85, I2 = 32 * 32;
    unsigned char* ws = A.ws;
    if (it < I1) return tr_desc(A.in[I_WIE], DM, NIN0, NIN0, (bf16_t*)(ws + WS_WT1), it / 85, it % 85, lane);
    it -= I1;
    if (it < I2) return tr_desc(A.in[I_WOE], DM, DM, DM, (bf16_t*)(ws + WS_WT2), it / 32, it % 32, lane);
    it -= I2;
    return tr_desc(A.in[I_WIO], DM, N3, N3, (bf16_t*)(ws + WS_WT3), it / 192, it % 192, lane);
}
__device__ __forceinline__ void p0_prologue(const Frame& F, const Args& A) {
    unsigned char* ws = A.ws;
    const int gtid = blockIdx.x * NTHREADS + F.tid, NT = F.G * NTHREADS;
    const int gw = blockIdx.x * NWAVES + F.wave, NGW = F.G * NWAVES;
    { f32x2* ROT = (f32x2*)(ws + WS_ROT);
      for (int idx = gtid; idx < 4100 * 128; idx += NT) { const int pi = idx >> 7, d = idx & 127;
          const float pos = (float)(pi < 4096 ? pi : 8192 + (pi - 4096));
          const float inv = powf(10000.f, -(float)d * (1.f / 128.f));
          float s, c; sincosf(pos * inv, &s, &c);
          ROT[idx] = (f32x2){c, s}; } }
    { u32x4* z = (u32x4*)((bf16_t*)(ws + WS_WT1) + (size_t)5440 * DM);
      for (int idx = gtid; idx < 192 * 256; idx += NT) z[idx] = (u32x4){0u, 0u, 0u, 0u}; }
    LAS float* scr = (LAS float*)(F.lds + F.wave * 16640);
    constexpr int NIT = 32 * 85;
    f32x4 va[16], vb[16]; TrItem da, db;
    int it = gw;
    if (it < NIT) { da = p0_tr_desc(A, it, F.lane); tr_load(da, va); }
#pragma unroll 1
    while (it < NIT) {
        const int it1 = it + NGW, it2 = it + 2 * NGW;
        if (it1 < NIT) { db = p0_tr_desc(A, it1, F.lane); tr_load(db, vb); }
        tr_finish(da, va, scr, F.lane);
        if (it1 >= NIT) break;
        if (it2 < NIT) { da = p0_tr_desc(A, it2, F.lane); tr_load(da, va); }
        tr_finish(db, vb, scr, F.lane);
        it = it2;
    }
}
constexpr int TRQ_TICKETS = (32 * 32 + 32 * 192) / 16;
__device__ __forceinline__ void tr_queue(const Frame& F, const Args& A, unsigned* head) {
    LAS float* scr = (LAS float*)(F.lds + F.wave * 16640);
    f32x4 va[16], vb[16];
    for (;;) { const int t = next_item(F, head); if (t >= TRQ_TICKETS) break;
        const int i0 = 32 * 85 + t * 16 + F.wave;
        const TrItem da = p0_tr_desc(A, i0, F.lane); tr_load(da, va);
        const TrItem db = p0_tr_desc(A, i0 + 8, F.lane); tr_load(db, vb);
        tr_finish(da, va, scr, F.lane); tr_finish(db, vb, scr, F.lane); }
}
__device__ __forceinline__ void wt4_transposes(const Frame& F, const Args& A, int blk0) {
    LAS float* scr = (LAS float*)(F.lds + F.wave * 16640);
    const int nw = (F.G - blk0) * NWAVES;
    bf16_t* WT4 = (bf16_t*)(A.ws + WS_WT4);
    f32x4 va[16], vb[16]; TrItem da, db;
    int it = ((int)blockIdx.x - blk0) * NWAVES + F.wave;
    if (it < 64 * 32) { da = tr_desc(A.in[I_WOO], KO1, DM, DM, WT4, it / 32, it % 32, F.lane); tr_load(da, va); }
#pragma unroll 1
    while (it < 64 * 32) {
        const int it1 = it + nw, it2 = it + 2 * nw;
        if (it1 < 64 * 32) { db = tr_desc(A.in[I_WOO], KO1, DM, DM, WT4, it1 / 32, it1 % 32, F.lane); tr_load(db, vb); }
        tr_finish(da, va, scr, F.lane);
        if (it1 >= 64 * 32) break;
        if (it2 < 64 * 32) { da = tr_desc(A.in[I_WOO], KO1, DM, DM, WT4, it2 / 32, it2 % 32, F.lane); tr_load(da, va); }
        tr_finish(db, vb, scr, F.lane);
        it = it2;
    }
}

__device__ __forceinline__ void p1_mods(const Frame& F, const Args& A) {
    LAS bf16_t* tile = (LAS bf16_t*)F.lds;
    LAS bf16_t* scs = tile + 256 * 136;
    const int lane = F.lane, g = lane >> 4, i = lane & 15, w = F.wave, tid = F.tid;
    const int k8 = (int)blockIdx.x & 7, kb = k8 * 256;
    {
        f32x4 cv[9][2];
#pragma unroll
        for (int j = 0; j < 9; ++j) { const int idx = tid + NTHREADS * j, r = idx >> 5, ch = idx & 31, rc = r < 130 ? r : 129;
            const float* cp = (rc < 2 ? A.in[I_CP] + (size_t)rc * DM : A.in[I_CS] + (size_t)(rc - 2) * DM) + kb + 8 * ch; cv[j][0] = *(const f32x4*)cp; cv[j][1] = *(const f32x4*)(cp + 4); }
#pragma unroll
        for (int j = 0; j < 9; ++j) { const int idx = tid + NTHREADS * j, r = idx >> 5, ch = idx & 31; const f32x4 v0 = cv[j][0], v1 = cv[j][1];
            u32x4 o; o.x = pk2_hw(silu_f(v0.x), silu_f(v0.y)); o.y = pk2_hw(silu_f(v0.z), silu_f(v0.w)); o.z = pk2_hw(silu_f(v1.x), silu_f(v1.y)); o.w = pk2_hw(silu_f(v1.z), silu_f(v1.w));
            if (r >= 130) o = (u32x4){0u, 0u, 0u, 0u};
            *(LAS u32x4*)(scs + r * 264 + 8 * ch) = o; }
    }
    for (int it = blockIdx.x; it < 768; it += F.G) {
        const int layer = it / 384, rem = it % 384, strip = rem >> 3, n0 = strip * 128;
        const float* W = layer ? A.in[I_AWO] : A.in[I_AWE];
        float* PART = (float*)(A.ws + WS_P1) + (size_t)(k8 * 2 + layer) * 130 * 6144;
        { const int c4 = lane & 31, r2 = lane >> 5;
          const float* wp = W + (size_t)(kb + 32 * w + r2) * 6144 + n0 + 4 * c4;
          f32x4 wv[16];
#pragma unroll
          for (int j = 0; j < 16; ++j) wv[j] = __builtin_nontemporal_load((const f32x4*)(wp + (size_t)(2 * j) * 6144));
#pragma unroll
          for (int j = 0; j < 16; ++j) { u32x2 o; o.x = pk2_hw(wv[j].x, wv[j].y); o.y = pk2_hw(wv[j].z, wv[j].w); *(LAS u32x2*)(tile + (32 * w + r2 + 2 * j) * 136 + 4 * c4) = o; } }
        __syncthreads();
        f32x4 acc[9];
#pragma unroll
        for (int m = 0; m < 9; ++m) acc[m] = (f32x4){0.f, 0.f, 0.f, 0.f};
#pragma unroll 2
        for (int ks = 0; ks < 8; ++ks) {
            const bf16x8 b = frag_tr(tile, 136, 16 * w, 32 * ks, lane);
#pragma unroll
            for (int m = 0; m < 9; ++m) acc[m] = MFMA16(frag_nat(scs, 264, 16 * m, 32 * ks, lane), b, acc[m]);
        }
        const int col = n0 + 16 * w + i;
#pragma unroll
        for (int m = 0; m < 9; ++m)
#pragma unroll
            for (int r = 0; r < 4; ++r) { const int row = 16 * m + 4 * g + r; if (row < 130) PART[(size_t)row * 6144 + col] = acc[m][r]; }
        __syncthreads();
    }
}
__device__ __forceinline__ void mods_reduce(const Frame& F, const Args& A) {
    constexpr int PER = 130 * 1536, NV = 2 * PER;
    const f32x4* P = (const f32x4*)(A.ws + WS_P1);
    for (int idx = blockIdx.x * NTHREADS + F.tid; idx < NV; idx += F.G * NTHREADS) {
        const int layer = idx >= PER ? 1 : 0, rem = idx - layer * PER, col4 = rem % 1536;
        f32x4 v[8];
#pragma unroll
        for (int k8 = 0; k8 < 8; ++k8) v[k8] = P[(size_t)(k8 * 2 + layer) * PER + rem];
        f32x4 s = *(const f32x4*)((layer ? A.in[I_ABO] : A.in[I_ABE]) + 4 * col4);
#pragma unroll
        for (int k8 = 0; k8 < 8; ++k8) s += v[k8];
        *(f32x4*)((float*)(A.ws + (layer ? WS_MOD1 : WS_MOD0)) + 4 * (size_t)rem) = s; }
}

__device__ __forceinline__ void norm_row_load(const Args& A, int layer, int row, int lane, f32x4 (&x)[8]) {
    if (layer) { const bf16_t* yr = (const bf16_t*)(A.ws + WS_Y1) + (size_t)row * DM + 4 * lane;
#pragma unroll
        for (int j = 0; j < 8; ++j) { const u32x2 w = *(const u32x2*)(yr + 256 * j); x[j] = (f32x4){bflo(w.x), bfhi(w.x), bflo(w.y), bfhi(w.y)}; } }
    else { const float* xr = (row < TP ? A.in[I_XP] + (size_t)row * DM : A.in[I_XS] + (size_t)(row - TP) * DM) + 4 * lane;
#pragma unroll
        for (int j = 0; j < 8; ++j) x[j] = *(const f32x4*)(xr + 256 * j); }
}
__device__ __forceinline__ void norm_phase(const Frame& F, const Args& A, int layer) {
    const float* MOD = (const float*)(A.ws + (layer ? WS_MOD1 : WS_MOD0));
    const float* gvec = layer ? A.in[I_NGO] : A.in[I_NGE];
    bf16_t* H = (bf16_t*)(A.ws + WS_H);
    const int gw = blockIdx.x * NWAVES + F.wave, NGW = F.G * NWAVES, lane = F.lane;
    f32x4 xn[8];
    if (gw < MROWS) norm_row_load(A, layer, gw, lane, xn);
#pragma unroll 1
    for (int row = gw; row < MROWS; row += NGW) {
        const int b = row < TP ? (row >> 12) : 2 + ((row - TP) >> 2);
        const float* shift = MOD + (size_t)b * 6144; const float* scale = shift + DM;
        f32x4 v[8], gg[8], sc[8], sh[8];
#pragma unroll
        for (int j = 0; j < 8; ++j) { const int c = 4 * lane + 256 * j; v[j] = xn[j]; gg[j] = *(const f32x4*)(gvec + c); sc[j] = *(const f32x4*)(scale + c); sh[j] = *(const f32x4*)(shift + c); }
        if (row + NGW < MROWS) norm_row_load(A, layer, row + NGW, lane, xn);
        __builtin_amdgcn_sched_barrier(0);
        float ss = 0.f;
#pragma unroll
        for (int j = 0; j < 8; ++j) ss += (v[j].x * v[j].x + v[j].y * v[j].y) + (v[j].z * v[j].z + v[j].w * v[j].w);
        const float r = rsqrtf(wave_sum(ss) * (1.f / DM) + EPS);
#pragma unroll
        for (int j = 0; j < 8; ++j) { const int c = 4 * lane + 256 * j;
            const f32x4 h = v[j] * r * gg[j] * (sc[j] + 1.f) + sh[j];
            u32x2 o; o.x = pk2_hw(h.x, h.y); o.y = pk2_hw(h.z, h.w);
            *(u32x2*)(H + (size_t)row * DM + c) = o; }
    }
}

struct EpiP0 {
    static constexpr bool PERM = true;
    bf16_t* P0; float* LR;
    __device__ __forceinline__ void operator()(const f32x4 (&acc)[2][2][4][2], const pg8::Unit& u, int wr, int wc, int fr, int fq) const {
        const int pn = u.pn, row0 = u.pm * 256 + wr * 64 + fr;
        if (pn == 21) {
            if (wc == 0 && fq < 2) {
#pragma unroll
                for (int ai = 0; ai < 2; ++ai)
#pragma unroll
                    for (int m = 0; m < 4; ++m) { float* p = LR + (size_t)(row0 + ai * 128 + m * 16) * 16 + 8 * fq;
                        *(f32x4*)p = acc[ai][0][m][0]; *(f32x4*)(p + 4) = acc[ai][0][m][1]; }
            }
            return;
        }
        const bool do_silu = (pn >= 5 && pn <= 8) || (pn >= 17);
        const float sc = (pn == 9 || pn == 10) ? 0.08838834764831845f : 1.f;
        const int col0 = pn * 256 + wc * 32 + 8 * fq;
#pragma unroll
        for (int ai = 0; ai < 2; ++ai)
#pragma unroll
            for (int m = 0; m < 4; ++m) { bf16_t* rowp = P0 + (size_t)(row0 + ai * 128 + m * 16) * N1 + col0;
#pragma unroll
                for (int bj = 0; bj < 2; ++bj) { f32x4 v0 = acc[ai][bj][m][0] * sc, v1 = acc[ai][bj][m][1] * sc;
                    if (do_silu) {
#pragma unroll
                        for (int j = 0; j < 4; ++j) { v0[j] = silu_f(v0[j]); v1[j] = silu_f(v1[j]); } }
                    u32x4 w; w.x = pg8::cvt_pk_bf16(v0[0], v0[1]); w.y = pg8::cvt_pk_bf16(v0[2], v0[3]); w.z = pg8::cvt_pk_bf16(v1[0], v1[1]); w.w = pg8::cvt_pk_bf16(v1[2], v1[3]);
                    *(u32x4*)(rowp + bj * 128) = w; } }
    }
};
struct EpiY1 {
    static constexpr bool PERM = true;
    const float* base0; const float* mod; bf16_t* out;
    __device__ __forceinline__ void operator()(const f32x4 (&acc)[2][2][4][2], const pg8::Unit& u, int wr, int wc, int fr, int fq) const {
        const int col0 = u.pn * 256 + wc * 32 + 8 * fq;
        const float* gp = mod + (size_t)(u.pm >> 4) * 6144 + 2 * DM + col0;
        f32x4 gt[2][2];
#pragma unroll
        for (int bj = 0; bj < 2; ++bj) { gt[bj][0] = *(const f32x4*)(gp + bj * 128); gt[bj][1] = *(const f32x4*)(gp + bj * 128 + 4); }
#pragma unroll
        for (int ai = 0; ai < 2; ++ai)
#pragma unroll
            for (int mh = 0; mh < 2; ++mh) {
                f32x4 xb[2][2][2];
#pragma unroll
                for (int m2 = 0; m2 < 2; ++m2) { const int row = u.pm * 256 + ai * 128 + wr * 64 + (2 * mh + m2) * 16 + fr; const float* bp = base0 + (size_t)row * DM + col0;
#pragma unroll
                    for (int bj = 0; bj < 2; ++bj) { xb[m2][bj][0] = *(const f32x4*)(bp + bj * 128); xb[m2][bj][1] = *(const f32x4*)(bp + bj * 128 + 4); } }
                __builtin_amdgcn_sched_barrier(0);
#pragma unroll
                for (int m2 = 0; m2 < 2; ++m2) { const int m = 2 * mh + m2, row = u.pm * 256 + ai * 128 + wr * 64 + m * 16 + fr; bf16_t* op = out + (size_t)row * DM + col0;
#pragma unroll
                    for (int bj = 0; bj < 2; ++bj) { const f32x4 v0 = xb[m2][bj][0] + gt[bj][0] * acc[ai][bj][m][0], v1 = xb[m2][bj][1] + gt[bj][1] * acc[ai][bj][m][1];
                        u32x4 w; w.x = pg8::cvt_pk_bf16(v0[0], v0[1]); w.y = pg8::cvt_pk_bf16(v0[2], v0[3]); w.z = pg8::cvt_pk_bf16(v1[0], v1[1]); w.w = pg8::cvt_pk_bf16(v1[2], v1[3]);
                        *(u32x4*)(op + bj * 128) = w; } }
                __builtin_amdgcn_sched_barrier(0); }
    }
};
struct EpiOut {
    static constexpr bool PERM = false;
    const bf16_t* base; const float* mod; float* out;
    __device__ __forceinline__ void operator()(const f32x4 (&acc)[2][2][4][2], const pg8::Unit& u, int wr, int wc, int fr, int fq) const {
        const int col0 = u.pn * 256 + wc * 32 + 4 * fq;
        const float* gp = mod + (size_t)(u.pm >> 4) * 6144 + 2 * DM + col0;
        f32x4 gt[2][2];
#pragma unroll
        for (int bj = 0; bj < 2; ++bj)
#pragma unroll
            for (int n = 0; n < 2; ++n) gt[bj][n] = *(const f32x4*)(gp + bj * 128 + n * 16);
#pragma unroll
        for (int ai = 0; ai < 2; ++ai) {
            u32x2 bw[4][2][2];
#pragma unroll
            for (int m = 0; m < 4; ++m) { const int row = u.pm * 256 + ai * 128 + wr * 64 + m * 16 + fr; const bf16_t* bp = base + (size_t)row * DM + col0;
#pragma unroll
                for (int bj = 0; bj < 2; ++bj)
#pragma unroll
                    for (int n = 0; n < 2; ++n) bw[m][bj][n] = *(const u32x2*)(bp + bj * 128 + n * 16); }
            __builtin_amdgcn_sched_barrier(0);
#pragma unroll
            for (int m = 0; m < 4; ++m) { const int row = u.pm * 256 + ai * 128 + wr * 64 + m * 16 + fr; float* op = out + (size_t)row * DM + col0;
#pragma unroll
                for (int bj = 0; bj < 2; ++bj)
#pragma unroll
                    for (int n = 0; n < 2; ++n) { const u32x2 w2 = bw[m][bj][n]; const f32x4 bs = (f32x4){bflo(w2.x), bfhi(w2.x), bflo(w2.y), bfhi(w2.y)};
                        *(f32x4*)(op + bj * 128 + n * 16) = bs + gt[bj][n] * acc[ai][bj][m][n]; } }
            __builtin_amdgcn_sched_barrier(0); }
    }
};
struct EpiP1 {
    static constexpr bool PERM = true;
    bf16_t* P1; const f32x2* ROT;
    __device__ __forceinline__ void operator()(const f32x4 (&acc)[2][2][4][2], const pg8::Unit& u, int wr, int wc, int fr, int fq) const {
        const int pn = u.pn, row0 = u.pm * 256 + wr * 64 + fr;
        const int col0 = pn * 256 + wc * 32 + 8 * fq;
        if (pn < 16) {
            const float ksc = pn >= 8 ? 0.0625f : 1.f;
            const int d0 = wc * 32 + 8 * fq;
#pragma unroll
            for (int ai = 0; ai < 2; ++ai)
#pragma unroll
                for (int m = 0; m < 4; ++m) { const int row = row0 + ai * 128 + m * 16;
                    const int pi = row < TP ? (row & 4095) : 4096 + (row & 3);
                    const f32x4* rp = (const f32x4*)(ROT + (size_t)pi * 128 + d0);
                    f32x4 o1[2], o2[2];
#pragma unroll
                    for (int n = 0; n < 2; ++n) { const f32x4 cs0 = rp[2 * n], cs1 = rp[2 * n + 1];
                        const f32x4 x1 = acc[ai][0][m][n], x2 = acc[ai][1][m][n];
                        const f32x4 c = (f32x4){cs0.x, cs0.z, cs1.x, cs1.z}, s = (f32x4){cs0.y, cs0.w, cs1.y, cs1.w};
                        o1[n] = (x1 * c - x2 * s) * ksc; o2[n] = (x2 * c + x1 * s) * ksc; }
                    bf16_t* rowp = P1 + (size_t)row * N3 + col0;
                    u32x4 w; w.x = pg8::cvt_pk_bf16(o1[0][0], o1[0][1]); w.y = pg8::cvt_pk_bf16(o1[0][2], o1[0][3]); w.z = pg8::cvt_pk_bf16(o1[1][0], o1[1][1]); w.w = pg8::cvt_pk_bf16(o1[1][2], o1[1][3]);
                    *(u32x4*)rowp = w;
                    w.x = pg8::cvt_pk_bf16(o2[0][0], o2[0][1]); w.y = pg8::cvt_pk_bf16(o2[0][2], o2[0][3]); w.z = pg8::cvt_pk_bf16(o2[1][0], o2[1][1]); w.w = pg8::cvt_pk_bf16(o2[1][2], o2[1][3]);
                    *(u32x4*)(rowp + 128) = w; }
            return;
        }
        const bool do_silu = pn >= 32;
#pragma unroll
        for (int ai = 0; ai < 2; ++ai)
#pragma unroll
            for (int m = 0; m < 4; ++m) { bf16_t* rowp = P1 + (size_t)(row0 + ai * 128 + m * 16) * N3 + col0;
#pragma unroll
                for (int bj = 0; bj < 2; ++bj) { f32x4 v0 = acc[ai][bj][m][0], v1 = acc[ai][bj][m][1];
                    if (do_silu) {
#pragma unroll
                        for (int j = 0; j < 4; ++j) { v0[j] = silu_f(v0[j]); v1[j] = silu_f(v1[j]); } }
                    u32x4 w; w.x = pg8::cvt_pk_bf16(v0[0], v0[1]); w.y = pg8::cvt_pk_bf16(v0[2], v0[3]); w.z = pg8::cvt_pk_bf16(v1[0], v1[1]); w.w = pg8::cvt_pk_bf16(v1[2], v1[3]);
                    *(u32x4*)(rowp + bj * 128) = w; } }
    }
};

template <bool OUT_BF16  >
__device__ __forceinline__ void mini_gemm_sample(const Frame& F, const bf16_t* A  , const bf16_t* Bt  , int K, const void* base1v, const float* mod, void* outv) {
    const int lane = F.lane, w = F.wave, g = lane >> 4, i15 = lane & 15, tid = F.tid;
    LAS float* part = (LAS float*)F.lds;
    for (int tile = blockIdx.x; tile < 256; tile += F.G) {
        const int r0 = (tile >> 5) * 64, c0 = (tile & 31) * 64;
        f32x4 acc[4][4];
#pragma unroll
        for (int m = 0; m < 4; ++m)
#pragma unroll
            for (int n = 0; n < 4; ++n) acc[m][n] = (f32x4){0.f, 0.f, 0.f, 0.f};
        const int kw = K >> 3, nks = kw >> 5;
        const bf16_t* ap = A + (size_t)(r0 + i15) * K + w * kw + 8 * g;
        const bf16_t* bp = Bt + (size_t)(c0 + i15) * K + w * kw + 8 * g;
#pragma unroll 1
        for (int ks = 0; ks < nks; ks += 4) {
            bf16x8 a[4][4], b[4][4];
#pragma unroll
            for (int u = 0; u < 4; ++u)
#pragma unroll
                for (int m = 0; m < 4; ++m) { a[u][m] = *(const bf16x8*)(ap + (size_t)(16 * m) * K + 32 * (ks + u)); b[u][m] = *(const bf16x8*)(bp + (size_t)(16 * m) * K + 32 * (ks + u)); }
            __builtin_amdgcn_sched_barrier(0);
#pragma unroll
            for (int u = 0; u < 4; ++u)
#pragma unroll
                for (int m = 0; m < 4; ++m)
#pragma unroll
                    for (int n = 0; n < 4; ++n) acc[m][n] = MFMA16(a[u][m], b[u][n], acc[m][n]);
            __builtin_amdgcn_sched_barrier(0);
        }
#pragma unroll
        for (int m = 0; m < 4; ++m)
#pragma unroll
            for (int n = 0; n < 4; ++n)
#pragma unroll
                for (int r = 0; r < 4; ++r) part[w * 4096 + (16 * m + 4 * g + r) * 64 + 16 * n + i15] = acc[m][n][r];
        __syncthreads();
        { const int row = tid >> 3, c8 = (tid & 7) * 8;
          f32x4 s0 = (f32x4){0.f, 0.f, 0.f, 0.f}, s1 = s0;
#pragma unroll
          for (int ww = 0; ww < 8; ++ww) { s0 += *(const LAS f32x4*)(part + ww * 4096 + row * 64 + c8); s1 += *(const LAS f32x4*)(part + ww * 4096 + row * 64 + c8 + 4); }
          const int rs = r0 + row, col = c0 + c8;
          const float* gp = mod + (size_t)(2 + (rs >> 2)) * 6144 + 2 * DM + col;
          if constexpr (OUT_BF16) { const float* bs = (const float*)base1v + (size_t)rs * DM + col; bf16_t* op = (bf16_t*)outv + (size_t)(TP + rs) * DM + col;
              const f32x4 v0 = *(const f32x4*)bs + *(const f32x4*)gp * s0, v1 = *(const f32x4*)(bs + 4) + *(const f32x4*)(gp + 4) * s1;
              u32x4 o; o.x = pk2_hw(v0.x, v0.y); o.y = pk2_hw(v0.z, v0.w); o.z = pk2_hw(v1.x, v1.y); o.w = pk2_hw(v1.z, v1.w); *(u32x4*)op = o; }
          else { const bf16_t* bs = (const bf16_t*)base1v + (size_t)rs * DM + col; float* op = (float*)outv + (size_t)(TP + rs) * DM + col;
              const u32x4 bw = *(const u32x4*)bs;
              *(f32x4*)op = (f32x4){bflo(bw.x), bfhi(bw.x), bflo(bw.y), bfhi(bw.y)} + *(const f32x4*)gp * s0;
              *(f32x4*)(op + 4) = (f32x4){bflo(bw.z), bfhi(bw.z), bflo(bw.w), bfhi(bw.w)} + *(const f32x4*)(gp + 4) * s1; } }
        __syncthreads();
    }
}

__device__ __forceinline__ int t5_bucket(int dist) {
    if (dist < 16) return dist;
    const float lr = __logf((float)dist * (1.f / 16.f)) * (1.f / 2.0794415416798357f);
    int large = 16 + (int)(lr * 16.f);
    return large < 31 ? large : 31;
}

__device__ __forceinline__ void swa_prompt_item(const Frame& F, const Args& A, int it) {
    const int b = it >> 6, blk = (it >> 1) & 31, kvh = it & 1;
    int tid = F.tid; asm volatile("" : "+v"(tid));
    const int lane = tid & 63, w = F.wave, g = lane >> 4, i15 = lane & 15, h = kvh * 8 + w;
    const bf16_t* P0 = (const bf16_t*)(A.ws + WS_P0);
    bf16_t* MIX = (bf16_t*)(A.ws + WS_MIX);
    LAS bf16_t* Ks = (LAS bf16_t*)F.lds;
    LAS bf16_t* Vs = Ks + 256 * 72;
    LAS bf16_t* Ps = Vs + 272 * 72;
    LAS float* bias = (LAS float*)(Ps + 8 * 16 * 168);
    const int row0 = b * SEQ + blk * 128;
    const float* qn_g = A.in[I_QNG]; const float* kn_g = A.in[I_KNG];
    { const int ch = tid & 7, rr0 = tid >> 3; const bool has_prev = blk > 0;
      u32x4 kv[4], vv4[4];
#pragma unroll
      for (int i = 0; i < 4; ++i) { const int s = rr0 + 64 * i;
          if (s >= 128 || has_prev) { const size_t grow = (size_t)(row0 - 128 + s) * N1;
              kv[i] = *(const u32x4*)(P0 + grow + C_KA + kvh * 64 + 8 * ch); vv4[i] = *(const u32x4*)(P0 + grow + C_VA + kvh * 64 + 8 * ch); }
          else { kv[i] = (u32x4){0u, 0u, 0u, 0u}; vv4[i] = kv[i]; } }
      float gk[8];
#pragma unroll
      for (int j = 0; j < 8; ++j) gk[j] = kn_g[8 * ch + j];
#pragma unroll
      for (int i = 0; i < 4; ++i) { const int s = rr0 + 64 * i; const unsigned ww[4] = {kv[i].x, kv[i].y, kv[i].z, kv[i].w}; float x[8]; float ss = 0.f;
#pragma unroll
          for (int j = 0; j < 4; ++j) { x[2 * j] = bflo(ww[j]); x[2 * j + 1] = bfhi(ww[j]); ss += x[2 * j] * x[2 * j] + x[2 * j + 1] * x[2 * j + 1]; }
          ss += __shfl_xor(ss, 1); ss += __shfl_xor(ss, 2); ss += __shfl_xor(ss, 4);
          const float r = rsqrtf(ss * (1.f / 64.f) + EPS);
#pragma unroll
          for (int j = 0; j < 8; ++j) x[j] = x[j] * r * gk[j];
          u32x4 o; o.x = pk2(x[0], x[1]); o.y = pk2(x[2], x[3]); o.z = pk2(x[4], x[5]); o.w = pk2(x[6], x[7]);
          *(LAS u32x4*)(Ks + s * 72 + 8 * ch) = o; *(LAS u32x4*)(Vs + s * 72 + 8 * ch) = vv4[i];
          if (blk == 31 && s >= 128) {
              float* kp = A.out + O_KP + ((size_t)(b * 128 + s - 128) * 2 + kvh) * 64 + 8 * ch;
              float* vp = A.out + O_VP + ((size_t)(b * 128 + s - 128) * 2 + kvh) * 64 + 8 * ch;
              *(f32x4*)kp = (f32x4){x[0], x[1], x[2], x[3]}; *(f32x4*)(kp + 4) = (f32x4){x[4], x[5], x[6], x[7]};
              *(f32x4*)vp = (f32x4){bflo(vv4[i].x), bfhi(vv4[i].x), bflo(vv4[i].y), bfhi(vv4[i].y)}; *(f32x4*)(vp + 4) = (f32x4){bflo(vv4[i].z), bfhi(vv4[i].z), bflo(vv4[i].w), bfhi(vv4[i].w)}; } }
      if (tid < 64) { *(LAS u32x4*)(Vs + (256 + (tid >> 2)) * 72 + 16 * (tid & 3)) = (u32x4){0u, 0u, 0u, 0u}; *(LAS u32x4*)(Vs + (256 + (tid >> 2)) * 72 + 16 * (tid & 3) + 8) = (u32x4){0u, 0u, 0u, 0u}; }
      for (int idx = tid; idx < 8 * 129; idx += NTHREADS) { const int hh = idx / 129, d = idx % 129; bias[hh * 132 + d] = A.in[I_RB][t5_bucket(d) * 16 + kvh * 8 + hh]; } }
    const float L2E = 1.4426950408889634f;
    const bf16_t* qp = P0 + (size_t)(row0 + i15) * N1 + C_QA + h * 64 + 8 * g;
    u32x4 qn0 = *(const u32x4*)qp, qn1 = *(const u32x4*)(qp + 32);
    float gq[2][8];
#pragma unroll
    for (int k2 = 0; k2 < 2; ++k2)
#pragma unroll
        for (int j = 0; j < 8; ++j) gq[k2][j] = qn_g[32 * k2 + 8 * g + j] * (0.125f * L2E);
    const float sink2 = A.in[I_SNK][h] * L2E;
    __syncthreads();
    const LAS float* bh_ = bias + w * 132;
    LAS bf16_t* Pw = Ps + w * 16 * 168;
    float bt[9][4];
#pragma unroll
    for (int j = 0; j < 9; ++j)
#pragma unroll
        for (int r = 0; r < 4; ++r) { const int dist = 128 - 16 * j + 4 * g + r - i15; const bool ok = dist >= 0 && dist <= 128; bt[j][r] = ok ? bh_[ok ? dist : 0] * L2E : -1e30f; }
#pragma unroll
    for (int r = 0; r < 4; ++r) Pw[(4 * g + r) * 168 + 144 + i15] = 0;
#pragma unroll 1
    for (int m = 0; m < 8; ++m) {
        u32x4 gv[2];
#pragma unroll
        for (int i = 0; i < 2; ++i) { const int idx = lane + 64 * i; gv[i] = *(const u32x4*)(P0 + (size_t)(row0 + 16 * m + (idx >> 3)) * N1 + C_GA + h * 64 + 8 * (idx & 7)); }
        const u32x4 qc0 = qn0, qc1 = qn1;
        { const int mn = m < 7 ? m + 1 : 7; qn0 = *(const u32x4*)(qp + (size_t)(16 * mn) * N1); qn1 = *(const u32x4*)(qp + (size_t)(16 * mn) * N1 + 32); }
        bf16x8 qf[2];
        { float x[2][8]; float ss = 0.f;
#pragma unroll
          for (int k2 = 0; k2 < 2; ++k2) { const u32x4 qq = k2 ? qc1 : qc0; const unsigned ww[4] = {qq.x, qq.y, qq.z, qq.w};
#pragma unroll
              for (int j = 0; j < 4; ++j) { x[k2][2 * j] = bflo(ww[j]); x[k2][2 * j + 1] = bfhi(ww[j]); ss += x[k2][2 * j] * x[k2][2 * j] + x[k2][2 * j + 1] * x[k2][2 * j + 1]; } }
          ss += __shfl_xor(ss, 16); ss += __shfl_xor(ss, 32);
          const float rq = rsqrtf(ss * (1.f / 64.f) + EPS);
#pragma unroll
          for (int k2 = 0; k2 < 2; ++k2) { u32x4 o; o.x = pk2_hw(x[k2][0] * rq * gq[k2][0], x[k2][1] * rq * gq[k2][1]); o.y = pk2_hw(x[k2][2] * rq * gq[k2][2], x[k2][3] * rq * gq[k2][3]);
              o.z = pk2_hw(x[k2][4] * rq * gq[k2][4], x[k2][5] * rq * gq[k2][5]); o.w = pk2_hw(x[k2][6] * rq * gq[k2][6], x[k2][7] * rq * gq[k2][7]); qf[k2] = __builtin_bit_cast(bf16x8, o); } }
        f32x4 sacc[9];
#pragma unroll
        for (int j = 0; j < 9; ++j) sacc[j] = (f32x4){0.f, 0.f, 0.f, 0.f};
#pragma unroll
        for (int ks = 0; ks < 2; ++ks)
#pragma unroll
            for (int j = 0; j < 9; ++j) sacc[j] = MFMA16(qf[ks], frag_nat(Ks, 72, 16 * (m + j), 32 * ks, lane), sacc[j]);
#pragma unroll
        for (int r = 0; r < 4; ++r) {
            float mx = -1e30f;
#pragma unroll
            for (int j = 0; j < 9; ++j) { const float v = (blk > 0 || m + j >= 8) ? sacc[j][r] + bt[j][r] : -1e30f;
                sacc[j][r] = v; mx = fmaxf(mx, v); }
            mx = fmaxf(red16_max(mx), sink2);
            float sum = 0.f;
#pragma unroll
            for (int j = 0; j < 9; ++j) { const float p = __builtin_amdgcn_exp2f(sacc[j][r] - mx); sacc[j][r] = p; sum += p; }
            sum = red16_sum(sum) + __builtin_amdgcn_exp2f(sink2 - mx);
            const float inv = __builtin_amdgcn_rcpf(sum);
            LAS bf16_t* pr = Pw + (4 * g + r) * 168 + i15;
#pragma unroll
            for (int j = 0; j < 8; j += 2) { const unsigned pk = pk2_hw(sacc[j][r] * inv, sacc[j + 1][r] * inv); pr[16 * j] = (bf16_t)pk; pr[16 * j + 16] = (bf16_t)(pk >> 16); }
            pr[128] = (bf16_t)f2bf_hw(sacc[8][r] * inv);
        }
        f32x4 oacc[4];
#pragma unroll
        for (int e = 0; e < 4; ++e) oacc[e] = (f32x4){0.f, 0.f, 0.f, 0.f};
#pragma unroll
        for (int ks = 0; ks < 5; ++ks) { const bf16x8 a = frag_nat(Pw, 168, 0, 32 * ks, lane);
#pragma unroll
            for (int e = 0; e < 4; ++e) oacc[e] = MFMA16(a, frag_tr(Vs, 72, 16 * e, 16 * m + 32 * ks, lane), oacc[e]); }
#pragma unroll
        for (int r = 0; r < 4; ++r) { LAS bf16_t* pr = Pw + (4 * g + r) * 168 + i15;
#pragma unroll
            for (int e = 0; e < 4; e += 2) { const unsigned pk = pk2_hw(oacc[e][r], oacc[e + 1][r]); pr[16 * e] = (bf16_t)pk; pr[16 * e + 16] = (bf16_t)(pk >> 16); } }
#pragma unroll
        for (int i = 0; i < 2; ++i) { const int idx = lane + 64 * i, tr_ = idx >> 3, c8 = idx & 7; const size_t t = (size_t)(row0 + 16 * m + tr_);
            const u32x4 ov = *(const LAS u32x4*)(Pw + tr_ * 168 + 8 * c8);
            const u32x4 gvv = gv[i];
            u32x4 o;
            o.x = pk2_hw(bflo(ov.x) * bflo(gvv.x), bfhi(ov.x) * bfhi(gvv.x)); o.y = pk2_hw(bflo(ov.y) * bflo(gvv.y), bfhi(ov.y) * bfhi(gvv.y));
            o.z = pk2_hw(bflo(ov.z) * bflo(gvv.z), bfhi(ov.z) * bfhi(gvv.z)); o.w = pk2_hw(bflo(ov.w) * bflo(gvv.w), bfhi(ov.w) * bfhi(gvv.w));
            *(u32x4*)(MIX + t * DM + h * 64 + 8 * c8) = o; }
    }
}

__device__ __forceinline__ void swa_sample_item(const Frame& F, const Args& A, int it) {
    const int bd = it >> 1, kvh = it & 1, tid = F.tid, lane = F.lane, w = F.wave, g = lane >> 4, i15 = lane & 15;
    const bf16_t* P0 = (const bf16_t*)(A.ws + WS_P0);
    bf16_t* MIX = (bf16_t*)(A.ws + WS_MIX);
    LAS bf16_t* Kb = (LAS bf16_t*)F.lds;
    LAS bf16_t* Vb = Kb + 144 * 72;
    LAS bf16_t* Qb = Vb + 160 * 72;
    LAS bf16_t* Pb = Qb + 32 * 72;
    LAS float* Ps = (LAS float*)(Pb + 32 * 168);
    LAS float* bias = Ps + 32 * 148;
    const size_t rowb = (size_t)TP + bd * 4;
    const float* ck = A.in[I_CK]; const float* cv = A.in[I_CV];
    float* oks = A.out + O_KS; float* ovs = A.out + O_VS;
    const int mt = w & 1, ntv = w >> 1;
    f32x4 kq[4], vq[4];
#pragma unroll
    for (int i = 0; i < 4; ++i) { const int idx = tid + NTHREADS * i, j = idx >> 4, d4 = (idx & 15) * 4;
        const size_t gi = ((size_t)(bd * 128 + j) * 2 + kvh) * 64 + d4; kq[i] = *(const f32x4*)(ck + gi); vq[i] = *(const f32x4*)(cv + gi); }
    bf16_t xqr[4], gar[4];
#pragma unroll
    for (int rr = 0; rr < 4; ++rr) { const int r = 4 * w + rr; xqr[rr] = P0[(rowb + (r >> 3)) * N1 + C_QA + (kvh * 8 + (r & 7)) * 64 + lane]; }
    const float gqn = A.in[I_QNG][lane], gkn = A.in[I_KNG][lane];
    const bf16_t xkr = P0[(rowb + (w & 3)) * N1 + C_KA + kvh * 64 + lane], xvr = P0[(rowb + (w & 3)) * N1 + C_VA + kvh * 64 + lane];
    float sk[4];
#pragma unroll
    for (int rr = 0; rr < 4; ++rr) sk[rr] = A.in[I_SNK][kvh * 8 + ((4 * w + rr) & 7)];
#pragma unroll
    for (int q = 0; q < 4; ++q) { const int r = 16 * mt + 4 * g + q; gar[q] = P0[(rowb + (r >> 3)) * N1 + C_GA + (kvh * 8 + (r & 7)) * 64 + 16 * ntv + i15]; }
    float bv[3];
#pragma unroll
    for (int i = 0; i < 3; ++i) { const int idx0 = tid + NTHREADS * i, idx = idx0 < 8 * 129 ? idx0 : 0, gq = idx / 129, dist = idx % 129; bv[i] = A.in[I_RB][t5_bucket(dist) * 16 + kvh * 8 + gq]; }
    __builtin_amdgcn_sched_barrier(0);
#pragma unroll
    for (int i = 0; i < 4; ++i) { const int idx = tid + NTHREADS * i, j = idx >> 4, d4 = (idx & 15) * 4;
        u32x2 kb, vb; kb.x = pk2_hw(kq[i].x, kq[i].y); kb.y = pk2_hw(kq[i].z, kq[i].w); vb.x = pk2_hw(vq[i].x, vq[i].y); vb.y = pk2_hw(vq[i].z, vq[i].w);
        *(LAS u32x2*)(Kb + j * 72 + d4) = kb; *(LAS u32x2*)(Vb + j * 72 + d4) = vb;
        if (j >= 4) { const size_t go = ((size_t)(bd * 128 + j - 4) * 2 + kvh) * 64 + d4; *(f32x4*)(oks + go) = kq[i]; *(f32x4*)(ovs + go) = vq[i]; } }
#pragma unroll
    for (int rr = 0; rr < 4; ++rr) { const int r = 4 * w + rr; const float x = bf2f(xqr[rr]); const float ss = wave_sum(x * x);
        Qb[r * 72 + lane] = (bf16_t)f2bf_hw(x * rsqrtf(ss * (1.f / 64.f) + EPS) * gqn * 0.125f); }
    { const float x = bf2f(xkr); const float ss = wave_sum(x * x);
      const float kn = x * rsqrtf(ss * (1.f / 64.f) + EPS) * gkn, vn = bf2f(xvr);
      if (w < 4) { Kb[(128 + w) * 72 + lane] = (bf16_t)f2bf_hw(kn); Vb[(128 + w) * 72 + lane] = (bf16_t)f2bf_hw(vn);
          const size_t go = ((size_t)(bd * 128 + 124 + w) * 2 + kvh) * 64 + lane; oks[go] = kn; ovs[go] = vn; } }
    if (tid < 108) *(LAS u32x4*)(Kb + 132 * 72 + 8 * tid) = (u32x4){0u, 0u, 0u, 0u};
    else if (tid >= 128 && tid < 128 + 252) *(LAS u32x4*)(Vb + 132 * 72 + 8 * (tid - 128)) = (u32x4){0u, 0u, 0u, 0u};
#pragma unroll
    for (int i = 0; i < 3; ++i) { const int idx = tid + NTHREADS * i; if (idx < 8 * 129) bias[(idx / 129) * 132 + idx % 129] = bv[i]; }
    __syncthreads();
    for (int nt = w; nt < 9; nt += 8) {
        const bf16x8 kb0 = frag_nat(Kb, 72, 16 * nt, 0, lane), kb1 = frag_nat(Kb, 72, 16 * nt, 32, lane);
#pragma unroll
        for (int m = 0; m < 2; ++m) { f32x4 acc = (f32x4){0.f, 0.f, 0.f, 0.f};
            acc = MFMA16(frag_nat(Qb, 72, 16 * m, 0, lane), kb0, acc); acc = MFMA16(frag_nat(Qb, 72, 16 * m, 32, lane), kb1, acc);
#pragma unroll
            for (int q = 0; q < 4; ++q) { const int r = 16 * m + 4 * g + q, l = r >> 3, gq = r & 7, s = 16 * nt + i15, dist = 128 + l - s;
                const bool ok = dist >= 0 && dist <= 128;
                Ps[r * 148 + s] = ok ? acc[q] + bias[gq * 132 + (ok ? dist : 0)] : -1e30f; } } }
    __syncthreads();
#pragma unroll
    for (int rr = 0; rr < 4; ++rr) { const int r = 4 * w + rr; const float sink = sk[rr];
        const float v0 = Ps[r * 148 + lane], v1 = Ps[r * 148 + 64 + lane], v2 = lane < 4 ? Ps[r * 148 + 128 + lane] : -1e30f;
        float mx = fmaxf(fmaxf(v0, v1), v2);
#pragma unroll
        for (int o = 1; o < 64; o <<= 1) mx = fmaxf(mx, __shfl_xor(mx, o));
        mx = fmaxf(mx, sink);
        const float p0 = __expf(v0 - mx), p1 = __expf(v1 - mx), p2 = lane < 4 ? __expf(v2 - mx) : 0.f;
        const float inv = 1.f / (wave_sum(p0 + p1 + p2) + __expf(sink - mx));
        Pb[r * 168 + lane] = (bf16_t)f2bf_hw(p0 * inv); Pb[r * 168 + 64 + lane] = (bf16_t)f2bf_hw(p1 * inv); if (lane < 40) Pb[r * 168 + 128 + lane] = (bf16_t)f2bf_hw(p2 * inv); }
    __syncthreads();
    { f32x4 o = (f32x4){0.f, 0.f, 0.f, 0.f};
#pragma unroll
      for (int ks = 0; ks < 5; ++ks) o = MFMA16(frag_nat(Pb, 168, 16 * mt, 32 * ks, lane), frag_tr(Vb, 72, 16 * ntv, 32 * ks, lane), o);
#pragma unroll
      for (int q = 0; q < 4; ++q) { const int r = 16 * mt + 4 * g + q;
          MIX[(rowb + (r >> 3)) * DM + (kvh * 8 + (r & 7)) * 64 + 16 * ntv + i15] = (bf16_t)f2bf_hw(o[q] * bf2f(gar[q])); } }
}

__device__ __forceinline__ void gla_sample_item(const Frame& F, const Args& A, int it) {
    const int bd = it >> 2, h = it & 3, tid = F.tid, lane = F.lane, w = F.wave;
    const bf16_t* P0 = (const bf16_t*)(A.ws + WS_P0);
    const float* LR = (const float*)(A.ws + WS_LR);
    bf16_t* MIX = (bf16_t*)(A.ws + WS_MIX);
    LAS float* qt = (LAS float*)F.lds;
    LAS float* kt = qt + 512;
    LAS float* kd = kt + 512;
    LAS float* dec = kd + 512;
    LAS float* vv = dec + 128;
    LAS float* Am = vv + 1024;
    LAS float* OACC = Am + 16;
    LAS float* red = OACC + 8 * 4 * 256;
    const size_t rowb = (size_t)TP + bd * 4;
    f32x4 s0[16];
    { const float* S0 = A.in[I_SG] + ((size_t)(bd * 4 + h) * 128 + (tid >> 6) * 16) * 256 + 4 * (tid & 63);
#pragma unroll
      for (int j = 0; j < 16; ++j) s0[j] = __builtin_nontemporal_load((const f32x4*)(S0 + (size_t)j * 256)); }
    if (tid < 128) { const int d = tid; float bc[4]; float run = 0.f;
        const float* wl = A.in[I_WLR] + h * 128 + d;
        float wv[16]; f32x4 lrv[16]; float qv[4], kv[4];
#pragma unroll
        for (int j = 0; j < 16; ++j) { wv[j] = wl[j * 512]; lrv[j] = *(const f32x4*)(LR + rowb * 16 + 4 * j); }
#pragma unroll
        for (int t = 0; t < 4; ++t) { qv[t] = bf2f(P0[(rowb + t) * N1 + C_QB + h * 128 + d]); kv[t] = bf2f(P0[(rowb + t) * N1 + C_KB + h * 128 + d]); }
        const float bl = A.in[I_BLR][h * 128 + d];
        __builtin_amdgcn_sched_barrier(0);
#pragma unroll
        for (int t = 0; t < 4; ++t) { float z = bl;
#pragma unroll
            for (int j4 = 0; j4 < 4; ++j4) { const f32x4 l = lrv[4 * t + j4]; z += l.x * wv[4 * j4] + l.y * wv[4 * j4 + 1] + l.z * wv[4 * j4 + 2] + l.w * wv[4 * j4 + 3]; }
            run += logsig_f(z) * (1.f / 16.f); bc[t] = run; }
#pragma unroll
        for (int t = 0; t < 4; ++t) { const float q = qv[t], k = kv[t];
            qt[t * 128 + d] = q * __expf(bc[t]); kt[t * 128 + d] = k * __expf(-bc[t]); kd[t * 128 + d] = k * __expf(bc[3] - bc[t]); }
        dec[d] = __expf(bc[3]); }
    { const int e = tid & 255, t0 = (tid >> 8) * 2;
      vv[t0 * 256 + e] = bf2f(P0[(rowb + t0) * N1 + C_VB + h * 256 + e]); vv[(t0 + 1) * 256 + e] = bf2f(P0[(rowb + t0 + 1) * N1 + C_VB + h * 256 + e]); }
    __syncthreads();
    { const int pair = tid >> 5, sub = tid & 31, t = pair >> 2, s = pair & 3; float p = 0.f;
#pragma unroll
      for (int i = 0; i < 4; ++i) p += qt[t * 128 + sub + 32 * i] * kt[s * 128 + sub + 32 * i];
      p += __shfl_xor(p, 1); p += __shfl_xor(p, 2); p += __shfl_xor(p, 4); p += __shfl_xor(p, 8); p += __shfl_xor(p, 16);
      if (sub == 0) Am[pair] = (s <= t) ? p : 0.f; }
    { const int e4 = tid & 63, dg = tid >> 6;
      const float* S0 = A.in[I_SG] + ((size_t)(bd * 4 + h) * 128 + dg * 16) * 256 + 4 * e4;
      float* SN = A.out + O_GS + ((size_t)(bd * 4 + h) * 128 + dg * 16) * 256 + 4 * e4;
      f32x4 vr[4];
#pragma unroll
      for (int t = 0; t < 4; ++t) vr[t] = *(const LAS f32x4*)(vv + t * 256 + 4 * e4);
      f32x4 oa[4];
#pragma unroll
      for (int t = 0; t < 4; ++t) oa[t] = (f32x4){0.f, 0.f, 0.f, 0.f};
      {
#pragma unroll
        for (int j = 0; j < 16; ++j) { const int d = dg * 16 + j;
            f32x4 sn = s0[j] * dec[d];
#pragma unroll
            for (int t = 0; t < 4; ++t) { sn += vr[t] * kd[t * 128 + d]; oa[t] += s0[j] * qt[t * 128 + d]; }
            __builtin_nontemporal_store(sn, (f32x4*)(SN + (size_t)j * 256)); } }
#pragma unroll
      for (int t = 0; t < 4; ++t) *(LAS f32x4*)(OACC + (dg * 4 + t) * 256 + 4 * e4) = oa[t]; }
    __syncthreads();
    { const int e = tid & 255, t0 = (tid >> 8) * 2; float o[2];
#pragma unroll
      for (int tt = 0; tt < 2; ++tt) { const int t = t0 + tt; float s = 0.f;
#pragma unroll
          for (int dgi = 0; dgi < 8; ++dgi) s += OACC[(dgi * 4 + t) * 256 + e];
#pragma unroll
          for (int s2 = 0; s2 < 4; ++s2) s += Am[t * 4 + s2] * vv[s2 * 256 + e];
          o[tt] = s; }
      const float s0 = wave_sum(o[0] * o[0]), s1 = wave_sum(o[1] * o[1]);
      if (lane == 0) { red[w * 2] = s0; red[w * 2 + 1] = s1; }
      __syncthreads();
      const int wb = (tid >> 8) * 4;
      const float q0 = red[wb * 2] + red[(wb + 1) * 2] + red[(wb + 2) * 2] + red[(wb + 3) * 2];
      const float q1 = red[wb * 2 + 1] + red[(wb + 1) * 2 + 1] + red[(wb + 2) * 2 + 1] + red[(wb + 3) * 2 + 1];
      const float gg = A.in[I_GLG][e];
      const float r0 = rsqrtf(q0 * (1.f / 256.f) + EPS), r1 = rsqrtf(q1 * (1.f / 256.f) + EPS);
      const float g0 = bf2f(P0[(rowb + t0) * N1 + C_GB + h * 256 + e]), g1 = bf2f(P0[(rowb + t0 + 1) * N1 + C_GB + h * 256 + e]);
      MIX[(rowb + t0) * DM + 1024 + h * 256 + e] = (bf16_t)f2bf(o[0] * r0 * gg * g0);
      MIX[(rowb + t0 + 1) * DM + 1024 + h * 256 + e] = (bf16_t)f2bf(o[1] * r1 * gg * g1); }
}

__device__ __forceinline__ void gla_state_item(const Frame& F, const Args& A, int it) {
    const int bh = it >> 3, db = it & 7, b = bh >> 2, h = bh & 3;
    const int tid = F.tid, lane = F.lane, w = F.wave, g = lane >> 4, i15 = lane & 15;
    const bf16_t* P0 = (const bf16_t*)(A.ws + WS_P0);
    const float* LR = (const float*)(A.ws + WS_LR);
    bf16_t* SPG = (bf16_t*)(A.ws + WS_SPG);
    LAS float* WL = (LAS float*)F.lds;
    LAS float* BL = WL + 256;
    LAS float* DEC = BL + 16;
    LAS bf16_t* KD = (LAS bf16_t*)(DEC + 32);
    LAS bf16_t* STW = KD + 2 * 64 * 24;
    LAS bf16_t* VS = STW + 4 * 64 * 16;
    if (tid < 256) WL[tid] = A.in[I_WLR][(tid >> 4) * 512 + h * 128 + db * 16 + (tid & 15)];
    if (tid < 16) BL[tid] = A.in[I_BLR][h * 128 + db * 16 + tid];
    __syncthreads();
    const size_t rowb = (size_t)b * SEQ;
    const bool prep = w < 4;
    const float* lp = LR + (rowb + lane) * 16;
    const bf16_t* kp = P0 + (rowb + lane) * N1 + C_KB + h * 128 + db * 16 + 4 * (w & 3);
    const bf16_t* vp = P0 + (rowb + ((tid & 255) >> 5)) * N1 + C_VB + h * 256 + 8 * (tid & 31);
    f32x4 lrA[4], lrB[4]; u32x2 kA = (u32x2){0u, 0u}, kB = kA; u32x4 vA[8], vB[8];
#define GSP_LOAD(LRR, KK, VV, cc) do { const size_t _o = (size_t)(cc) * 64; \
        _Pragma("unroll") for (int _j = 0; _j < 4; ++_j) LRR[_j] = *(const f32x4*)(lp + _o * 16 + 4 * _j); \
        KK = *(const u32x2*)(kp + _o * N1); \
        _Pragma("unroll") for (int _i = 0; _i < 8; ++_i) VV[_i] = *(const u32x4*)(vp + (_o + 8 * _i) * N1); } while (0)
#define GSP_PREP(LRR, KK, VV, nb) do { \
        f32x4 _zz = blr; \
        _Pragma("unroll") for (int _j = 0; _j < 4; ++_j) { _zz += wlr[4 * _j] * LRR[_j].x; _zz += wlr[4 * _j + 1] * LRR[_j].y; _zz += wlr[4 * _j + 2] * LRR[_j].z; _zz += wlr[4 * _j + 3] * LRR[_j].w; } \
        const float _z[4] = {_zz.x, _zz.y, _zz.z, _zz.w}; \
        float _bc[4], _tot[4]; \
        _Pragma("unroll") for (int _q = 0; _q < 4; ++_q) { const float _v = wave_incl_scan(logsig_f(_z[_q]) * (1.f / 16.f)); \
            _bc[_q] = _v; _tot[_q] = __builtin_bit_cast(float, __builtin_amdgcn_readlane(__builtin_bit_cast(int, _v), 63)); } \
        const float _k0 = bflo(KK.x), _k1 = bfhi(KK.x), _k2 = bflo(KK.y), _k3 = bfhi(KK.y); \
        u32x2 _o2; _o2.x = pg8::cvt_pk_bf16(_k0 * __expf(_tot[0] - _bc[0]), _k1 * __expf(_tot[1] - _bc[1])); _o2.y = pg8::cvt_pk_bf16(_k2 * __expf(_tot[2] - _bc[2]), _k3 * __expf(_tot[3] - _bc[3])); \
        *(LAS u32x2*)(KD + (nb) * (64 * 24) + lane * 24 + 4 * (w & 3)) = _o2; \
        if (lane == 0) { _Pragma("unroll") for (int _q = 0; _q < 4; ++_q) DEC[(nb) * 16 + 4 * (w & 3) + _q] = __expf(_tot[_q]); } \
        _Pragma("unroll") for (int _i = 0; _i < 8; ++_i) *(LAS u32x4*)(VS + (nb) * (64 * 264) + (((tid & 255) >> 5) + 8 * _i) * 264 + 8 * (tid & 31)) = VV[_i]; } while (0)
    f32x4 wlr[16], blr;
#pragma unroll
    for (int j = 0; j < 16; ++j) wlr[j] = *(const LAS f32x4*)(WL + j * 16 + 4 * (w & 3));
    blr = *(const LAS f32x4*)(BL + 4 * (w & 3));
    const int mw = w & 3;
    f32x4 S[4];
#pragma unroll
    for (int n = 0; n < 4; ++n) S[n] = (f32x4){0.f, 0.f, 0.f, 0.f};
    LAS bf16_t* stw = STW + mw * (64 * 16);
#define GSC_STEP(cc) do { const int _cb = (cc) & 1; \
        _Pragma("unroll") for (int _n = 0; _n < 4; ++_n) { const unsigned _p0 = pg8::cvt_pk_bf16(S[_n][0], S[_n][1]), _p1 = pg8::cvt_pk_bf16(S[_n][2], S[_n][3]); \
            stw[(16 * _n + 4 * g + 0) * 16 + i15] = (bf16_t)_p0; stw[(16 * _n + 4 * g + 1) * 16 + i15] = (bf16_t)(_p0 >> 16); \
            stw[(16 * _n + 4 * g + 2) * 16 + i15] = (bf16_t)_p1; stw[(16 * _n + 4 * g + 3) * 16 + i15] = (bf16_t)(_p1 >> 16); } \
        { bf16_t* _dst = SPG + ((size_t)(bh * 64 + (cc)) * 256 + 64 * mw + lane) * 128 + db * 16; \
          *(u32x4*)_dst = *(const LAS u32x4*)(stw + lane * 16); *(u32x4*)(_dst + 8) = *(const LAS u32x4*)(stw + lane * 16 + 8); } \
        f32x4 _nw[4]; \
        _Pragma("unroll") for (int _n = 0; _n < 4; ++_n) _nw[_n] = (f32x4){0.f, 0.f, 0.f, 0.f}; \
        _Pragma("unroll") for (int _ks = 0; _ks < 2; ++_ks) { const bf16x8 _bb = frag_tr(KD + _cb * (64 * 24), 24, 0, 32 * _ks, lane); \
            _Pragma("unroll") for (int _n = 0; _n < 4; ++_n) _nw[_n] = MFMA16(frag_tr(VS + _cb * (64 * 264), 264, 64 * mw + 16 * _n, 32 * _ks, lane), _bb, _nw[_n]); } \
        const float _dc = DEC[_cb * 16 + i15]; \
        _Pragma("unroll") for (int _n = 0; _n < 4; ++_n) S[_n] = S[_n] * _dc + _nw[_n]; } while (0)
    if (prep) { GSP_LOAD(lrA, kA, vA, 0); GSP_LOAD(lrB, kB, vB, 1); GSP_PREP(lrA, kA, vA, 0); GSP_LOAD(lrA, kA, vA, 2); }
    __syncthreads();
#pragma unroll 1
    for (int c = 0; c < 64; c += 2) {
        if (prep) { GSP_PREP(lrB, kB, vB, 1); if (c + 3 < 64) GSP_LOAD(lrB, kB, vB, c + 3); }
        else GSC_STEP(c);
        __syncthreads();
        if (prep) { if (c + 2 < 64) { GSP_PREP(lrA, kA, vA, 0); if (c + 4 < 64) GSP_LOAD(lrA, kA, vA, c + 4); } }
        else GSC_STEP(c + 1);
        __syncthreads();
    }
#undef GSP_LOAD
#undef GSP_PREP
#undef GSC_STEP
    if (!prep) { int ln = lane; asm volatile("" : "+v"(ln));
        float* gp = A.out + O_GP + ((size_t)bh * 128 + db * 16 + (ln & 15)) * 256 + 64 * mw + 4 * (ln >> 4);
#pragma unroll
        for (int n = 0; n < 4; ++n) *(f32x4*)(gp + 16 * n) = S[n]; }
}

__device__ __forceinline__ void gla_out_item(const Frame& F, const Args& A, int it) {
    const int bh = it >> 6, c = it & 63, b = bh >> 2, h = bh & 3;
    const int tid = F.tid, lane = F.lane, w = F.wave, g = lane >> 4, i15 = lane & 15;
    const bf16_t* P0 = (const bf16_t*)(A.ws + WS_P0);
    const float* LR = (const float*)(A.ws + WS_LR);
    const bf16_t* SPG = (const bf16_t*)(A.ws + WS_SPG);
    bf16_t* MIX = (bf16_t*)(A.ws + WS_MIX);
    LAS float* WL = (LAS float*)F.lds;
    LAS float* BL = WL + 2048;
    LAS float* LRs = BL + 128;
    LAS float* LA = LRs + 1024;
    LAS float* SEG = LA + 64 * 129;
    LAS bf16_t* QT = (LAS bf16_t*)(SEG + 512);
    LAS bf16_t* KT = QT + 64 * 136;
    LAS bf16_t* VS = KT + 64 * 136;
    LAS bf16_t* AM = VS + 64 * 264;
    LAS float* RS = (LAS float*)(AM + 64 * 72);
    const size_t row0 = (size_t)b * SEQ + c * 64;
    const int t8 = tid >> 3, c8 = tid & 7;
    const bf16_t* qsrc = P0 + (row0 + t8) * N1 + C_QB + h * 128 + 16 * c8;
    const bf16_t* ksrc = P0 + (row0 + t8) * N1 + C_KB + h * 128 + 16 * c8;
    const u32x4 q0 = *(const u32x4*)qsrc, q1 = *(const u32x4*)(qsrc + 8), k0 = *(const u32x4*)ksrc, k1 = *(const u32x4*)(ksrc + 8);
    { const bf16_t* vsrc = P0 + (row0 + t8) * N1 + C_VB + h * 256 + 32 * c8;
#pragma unroll
      for (int j = 0; j < 4; ++j) *(LAS u32x4*)(VS + t8 * 264 + 32 * c8 + 8 * j) = *(const u32x4*)(vsrc + 8 * j); }
    { float wv[4];
#pragma unroll
      for (int i = 0; i < 4; ++i) { const int idx = tid + NTHREADS * i; wv[i] = A.in[I_WLR][(idx >> 7) * 512 + h * 128 + (idx & 127)]; }
      const float blv = A.in[I_BLR][h * 128 + (tid & 127)];
      const f32x4 lv = *(const f32x4*)(LR + row0 * 16 + 4 * (tid & 255));
#pragma unroll
      for (int i = 0; i < 4; ++i) WL[tid + NTHREADS * i] = wv[i];
      if (tid < 128) BL[tid] = blv;
      if (tid < 256) *(LAS f32x4*)(LRs + 4 * tid) = lv; }
    __syncthreads();
    { float lr[16];
#pragma unroll
      for (int j = 0; j < 16; ++j) lr[j] = LRs[t8 * 16 + j];
#pragma unroll
      for (int q = 0; q < 16; ++q) { const int d = 16 * c8 + q; float z = BL[d];
#pragma unroll
          for (int j = 0; j < 16; ++j) z += lr[j] * WL[j * 128 + d];
          LA[t8 * 129 + d] = logsig_f(z) * (1.f / 16.f); } }
    __syncthreads();
    { const int d = tid & 127, seg = tid >> 7; float p[16]; float run = 0.f;
#pragma unroll
      for (int q = 0; q < 16; ++q) { run += LA[(16 * seg + q) * 129 + d]; p[q] = run; }
      SEG[seg * 128 + d] = run;
      __syncthreads();
      float off = 0.f;
#pragma unroll
      for (int s2 = 0; s2 < 3; ++s2) off += (s2 < seg) ? SEG[s2 * 128 + d] : 0.f;
#pragma unroll
      for (int q = 0; q < 16; ++q) LA[(16 * seg + q) * 129 + d] = off + p[q]; }
    __syncthreads();
    { const unsigned qw[8] = {q0.x, q0.y, q0.z, q0.w, q1.x, q1.y, q1.z, q1.w}, kw[8] = {k0.x, k0.y, k0.z, k0.w, k1.x, k1.y, k1.z, k1.w};
      unsigned qo[8], ko[8];
#pragma unroll
      for (int j = 0; j < 8; ++j) { const float b0 = LA[t8 * 129 + 16 * c8 + 2 * j], b1 = LA[t8 * 129 + 16 * c8 + 2 * j + 1];
          qo[j] = pk2_hw(bflo(qw[j]) * __expf(b0), bfhi(qw[j]) * __expf(b1)); ko[j] = pk2_hw(bflo(kw[j]) * __expf(-b0), bfhi(kw[j]) * __expf(-b1)); }
      *(LAS u32x4*)(QT + t8 * 136 + 16 * c8) = (u32x4){qo[0], qo[1], qo[2], qo[3]}; *(LAS u32x4*)(QT + t8 * 136 + 16 * c8 + 8) = (u32x4){qo[4], qo[5], qo[6], qo[7]};
      *(LAS u32x4*)(KT + t8 * 136 + 16 * c8) = (u32x4){ko[0], ko[1], ko[2], ko[3]}; *(LAS u32x4*)(KT + t8 * 136 + 16 * c8 + 8) = (u32x4){ko[4], ko[5], ko[6], ko[7]}; }
    __syncthreads();
    { const int tt = w >> 1, st0 = 2 * (w & 1);
      f32x4 a0 = (f32x4){0.f, 0.f, 0.f, 0.f}, a1 = a0;
#pragma unroll
      for (int ks = 0; ks < 4; ++ks) { const bf16x8 a = frag_nat(QT, 136, 16 * tt, 32 * ks, lane);
          a0 = MFMA16(a, frag_nat(KT, 136, 16 * st0, 32 * ks, lane), a0); a1 = MFMA16(a, frag_nat(KT, 136, 16 * st0 + 16, 32 * ks, lane), a1); }
#pragma unroll
      for (int r = 0; r < 4; ++r) { const int t = 16 * tt + 4 * g + r, s0 = 16 * st0 + i15, s1 = s0 + 16;
          AM[t * 72 + s0] = (bf16_t)f2bf_hw(s0 <= t ? a0[r] : 0.f); AM[t * 72 + s1] = (bf16_t)f2bf_hw(s1 <= t ? a1[r] : 0.f); } }
    __syncthreads();
    f32x4 acc[4][2];
#pragma unroll
    for (int m = 0; m < 4; ++m) { acc[m][0] = (f32x4){0.f, 0.f, 0.f, 0.f}; acc[m][1] = acc[m][0]; }
#pragma unroll
    for (int ks = 0; ks < 2; ++ks) { const bf16x8 b0 = frag_tr(VS, 264, 32 * w, 32 * ks, lane), b1 = frag_tr(VS, 264, 32 * w + 16, 32 * ks, lane);
#pragma unroll
        for (int m = 0; m < 4; ++m) { const bf16x8 a = frag_nat(AM, 72, 16 * m, 32 * ks, lane); acc[m][0] = MFMA16(a, b0, acc[m][0]); acc[m][1] = MFMA16(a, b1, acc[m][1]); } }
    { const bf16_t* sp = SPG + ((size_t)(bh * 64 + c) * 256 + 32 * w + i15) * 128 + 8 * g;
      bf16x8 sb[4][2];
#pragma unroll
      for (int ks = 0; ks < 4; ++ks) { sb[ks][0] = *(const bf16x8*)(sp + 32 * ks); sb[ks][1] = *(const bf16x8*)(sp + 16 * 128 + 32 * ks); }
      __builtin_amdgcn_sched_barrier(0);
#pragma unroll
      for (int ks = 0; ks < 4; ++ks) {
#pragma unroll
          for (int m = 0; m < 4; ++m) { const bf16x8 a = frag_nat(QT, 136, 16 * m, 32 * ks, lane); acc[m][0] = MFMA16(a, sb[ks][0], acc[m][0]); acc[m][1] = MFMA16(a, sb[ks][1], acc[m][1]); } } }
#pragma unroll
    for (int m = 0; m < 4; ++m)
#pragma unroll
        for (int r = 0; r < 4; ++r) { float ss = acc[m][0][r] * acc[m][0][r] + acc[m][1][r] * acc[m][1][r]; ss = red16_sum(ss); if (i15 == 0) RS[w * 64 + 16 * m + 4 * g + r] = ss; }
    __syncthreads();
    { const float g0 = A.in[I_GLG][32 * w + i15], g1 = A.in[I_GLG][32 * w + 16 + i15];
#pragma unroll
      for (int m = 0; m < 4; ++m)
#pragma unroll
          for (int r = 0; r < 4; ++r) { const int t = 16 * m + 4 * g + r; float q = 0.f;
#pragma unroll
              for (int ww = 0; ww < 8; ++ww) q += RS[ww * 64 + t];
              const float rr = rsqrtf(q * (1.f / 256.f) + EPS);
              VS[t * 264 + 32 * w + i15] = (bf16_t)f2bf_hw(acc[m][0][r] * rr * g0);
              VS[t * 264 + 32 * w + 16 + i15] = (bf16_t)f2bf_hw(acc[m][1][r] * rr * g1); } }
    u32x4 gva[4];
#pragma unroll
    for (int i = 0; i < 4; ++i) { const int idx = tid + NTHREADS * i, t = idx >> 5, ch = idx & 31; gva[i] = *(const u32x4*)(P0 + (row0 + t) * N1 + C_GB + h * 256 + 8 * ch); }
    __syncthreads();
#pragma unroll
    for (int i = 0; i < 4; ++i) { const int idx = tid + NTHREADS * i, t = idx >> 5, ch = idx & 31;
        const u32x4 ov = *(const LAS u32x4*)(VS + t * 264 + 8 * ch);
        const u32x4 gv = gva[i];
        u32x4 o;
        o.x = pk2_hw(bflo(ov.x) * bflo(gv.x), bfhi(ov.x) * bfhi(gv.x)); o.y = pk2_hw(bflo(ov.y) * bflo(gv.y), bfhi(ov.y) * bfhi(gv.y));
        o.z = pk2_hw(bflo(ov.z) * bflo(gv.z), bfhi(ov.z) * bfhi(gv.z)); o.w = pk2_hw(bflo(ov.w) * bflo(gv.w), bfhi(ov.w) * bfhi(gv.w));
        *(u32x4*)(MIX + (row0 + t) * DM + 1024 + h * 256 + 8 * ch) = o; }
}

__device__ __forceinline__ float ret_log2_gamma(int h) { return log1pf(-exp2f(-5.f - (float)h)) * 1.4426950408889634f; }

__device__ __forceinline__ void ret_sample_item(const Frame& F, const Args& A, int it) {
    const int bd = it >> 3, h = it & 7, tid = F.tid, lane = F.lane, w = F.wave;
    const bf16_t* P1 = (const bf16_t*)(A.ws + WS_P1);
    bf16_t* RO = (bf16_t*)(A.ws + WS_RO);
    LAS float* q = (LAS float*)F.lds;
    LAS float* k = q + 1024;
    LAS float* vv = k + 1024;
    LAS float* Am = vv + 2048;
    LAS float* red = Am + 16;
    LAS float* OACC = red + 16;
    const size_t rowb = (size_t)TP + bd * 4;
    const float l2g = ret_log2_gamma(h);
    { const int d = tid & 255, t0 = (tid >> 8) * 2;
#pragma unroll
      for (int tt = 0; tt < 2; ++tt) { const int t = t0 + tt; q[t * 256 + d] = bf2f(P1[(rowb + t) * N3 + C_Q + h * 256 + d]); k[t * 256 + d] = bf2f(P1[(rowb + t) * N3 + C_K + h * 256 + d]); } }
#pragma unroll
    for (int t = 0; t < 4; ++t) vv[t * 512 + tid] = bf2f(P1[(rowb + t) * N3 + C_V + h * 512 + tid]);
    __syncthreads();
    { const int pair = tid >> 5, sub = tid & 31, t = pair >> 2, s = pair & 3; float p = 0.f;
#pragma unroll
      for (int i = 0; i < 8; ++i) p += q[t * 256 + sub + 32 * i] * k[s * 256 + sub + 32 * i];
      p += __shfl_xor(p, 1); p += __shfl_xor(p, 2); p += __shfl_xor(p, 4); p += __shfl_xor(p, 8); p += __shfl_xor(p, 16);
      if (sub == 0) Am[pair] = (s <= t) ? p * exp2f(l2g * (float)(t - s)) : 0.f; }
    { const int e4 = tid & 127, dg = tid >> 7;
      const float* S0 = A.in[I_SR] + ((size_t)(bd * 8 + h) * 256 + dg * 64) * 512 + 4 * e4;
      float* SN = A.out + O_RS + ((size_t)(bd * 8 + h) * 256 + dg * 64) * 512 + 4 * e4;
      f32x4 vr[4];
      const float kdsc[4] = {exp2f(l2g * 3.f), exp2f(l2g * 2.f), exp2f(l2g), 1.f};
#pragma unroll
      for (int t = 0; t < 4; ++t) vr[t] = *(const LAS f32x4*)(vv + t * 512 + 4 * e4) * kdsc[t];
      const float g4 = exp2f(l2g * 4.f);
      f32x4 oa[4];
#pragma unroll
      for (int t = 0; t < 4; ++t) oa[t] = (f32x4){0.f, 0.f, 0.f, 0.f};
#pragma unroll 1
      for (int i0 = 0; i0 < 64; i0 += 32) {
          f32x4 s0[32];
#pragma unroll
          for (int j = 0; j < 32; ++j) s0[j] = __builtin_nontemporal_load((const f32x4*)(S0 + (size_t)(i0 + j) * 512));
#pragma unroll
          for (int j = 0; j < 32; ++j) { const int d = dg * 64 + i0 + j;
              f32x4 sn = s0[j] * g4;
#pragma unroll
              for (int t = 0; t < 4; ++t) { sn += vr[t] * k[t * 256 + d]; oa[t] += s0[j] * q[t * 256 + d]; }
              __builtin_nontemporal_store(sn, (f32x4*)(SN + (size_t)(i0 + j) * 512)); } }
#pragma unroll
      for (int t = 0; t < 4; ++t) *(LAS f32x4*)(OACC + (dg * 4 + t) * 512 + 4 * e4) = oa[t]; }
    __syncthreads();
    { const int e = tid; float o[4];
#pragma unroll
      for (int t = 0; t < 4; ++t) { float s = 0.f;
#pragma unroll
          for (int dgi = 0; dgi < 4; ++dgi) s += OACC[(dgi * 4 + t) * 512 + e];
          s *= exp2f(l2g * (float)(t + 1));
#pragma unroll
          for (int s2 = 0; s2 < 4; ++s2) s += Am[t * 4 + s2] * vv[s2 * 512 + e];
          o[t] = s; }
      const float gg = A.in[I_RTG][e];
      bf16_t gsr[4];
#pragma unroll
      for (int t = 0; t < 4; ++t) gsr[t] = P1[(rowb + t) * N3 + C_G + h * 512 + e];
      float ssq[4];
#pragma unroll
      for (int t = 0; t < 4; ++t) ssq[t] = wave_sum(o[t] * o[t]);
      __syncthreads();
      if (lane == 0) {
#pragma unroll
          for (int t = 0; t < 4; ++t) OACC[w * 4 + t] = ssq[t]; }
      __syncthreads();
#pragma unroll
      for (int t = 0; t < 4; ++t) { float qsum = 0.f;
#pragma unroll
          for (int ww = 0; ww < 8; ++ww) qsum += OACC[ww * 4 + t];
          const float rr = rsqrtf(qsum * (1.f / 512.f) + EPS);
          const float gs = bf2f(gsr[t]);
          RO[(rowb + t) * KO1 + h * 512 + e] = (bf16_t)f2bf_hw(o[t] * rr * gg * gs); } }
}

__device__ __forceinline__ void ret_state_item(const Frame& F, const Args& A, int it) {
    const int bh = it >> 3, eb = (it >> 1) & 3, db = it & 1, b = bh >> 3, h = bh & 7;
    const int tid = F.tid, lane = F.lane, w = F.wave, g = lane >> 4, i15 = lane & 15;
    const bf16_t* P1 = (const bf16_t*)(A.ws + WS_P1);
    bf16_t* SPR = (bf16_t*)(A.ws + WS_SPR);
    LAS bf16_t* KD = (LAS bf16_t*)F.lds;
    LAS bf16_t* VS = KD + 128 * 136;
    LAS bf16_t* ST = VS + 128 * 136;
    const float l2g = ret_log2_gamma(h);
    const float g128 = exp2f(l2g * 128.f);
    const int we = w >> 2, wd = w & 3;
    const int r0 = tid >> 4, ch = tid & 15;
    float ksc[4];
#pragma unroll
    for (int i = 0; i < 4; ++i) ksc[i] = exp2f(l2g * (float)(127 - (r0 + 32 * i)));
    f32x4 S[4][2];
#pragma unroll
    for (int m = 0; m < 4; ++m) { S[m][0] = (f32x4){0.f, 0.f, 0.f, 0.f}; S[m][1] = S[m][0]; }
    const bf16_t* kp = P1 + ((size_t)b * SEQ + r0) * N3 + C_K + h * 256 + db * 128 + 8 * ch;
    const bf16_t* vp = P1 + ((size_t)b * SEQ + r0) * N3 + C_V + h * 512 + eb * 128 + 8 * ch;
    u32x4 kr[4], vr[4];
#pragma unroll
    for (int i = 0; i < 4; ++i) { kr[i] = *(const u32x4*)(kp + (size_t)(32 * i) * N3); vr[i] = *(const u32x4*)(vp + (size_t)(32 * i) * N3); }
    for (int c = 0; c < 32; ++c) {
#pragma unroll
        for (int i = 0; i < 4; ++i) { const float sc = ksc[i]; u32x4 o;
            o.x = pk2_hw(bflo(kr[i].x) * sc, bfhi(kr[i].x) * sc); o.y = pk2_hw(bflo(kr[i].y) * sc, bfhi(kr[i].y) * sc); o.z = pk2_hw(bflo(kr[i].z) * sc, bfhi(kr[i].z) * sc); o.w = pk2_hw(bflo(kr[i].w) * sc, bfhi(kr[i].w) * sc);
            *(LAS u32x4*)(KD + (r0 + 32 * i) * 136 + 8 * ch) = o; *(LAS u32x4*)(VS + (r0 + 32 * i) * 136 + 8 * ch) = vr[i]; }
        if (c + 1 < 32) { kp += (size_t)128 * N3; vp += (size_t)128 * N3;
#pragma unroll
            for (int i = 0; i < 4; ++i) { kr[i] = *(const u32x4*)(kp + (size_t)(32 * i) * N3); vr[i] = *(const u32x4*)(vp + (size_t)(32 * i) * N3); } }
#pragma unroll
        for (int m = 0; m < 4; ++m)
#pragma unroll
            for (int n = 0; n < 2; ++n)
#pragma unroll
                for (int r = 0; r < 4; ++r) ST[(64 * we + 16 * m + 4 * g + r) * 136 + 32 * wd + 16 * n + i15] = (bf16_t)f2bf_hw(S[m][n][r]);
        __syncthreads();
        { bf16_t* dst = SPR + ((size_t)(bh * 32 + c) * 512 + eb * 128 + r0) * 256 + db * 128 + 8 * ch;
#pragma unroll
          for (int i = 0; i < 4; ++i) *(u32x4*)(dst + (size_t)(32 * i) * 256) = *(const LAS u32x4*)(ST + (r0 + 32 * i) * 136 + 8 * ch); }
        { f32x4 nw[4][2];
#pragma unroll
          for (int m = 0; m < 4; ++m) { nw[m][0] = (f32x4){0.f, 0.f, 0.f, 0.f}; nw[m][1] = nw[m][0]; }
#pragma unroll
          for (int ks = 0; ks < 4; ++ks) { const bf16x8 b0 = frag_tr(KD, 136, 32 * wd, 32 * ks, lane), b1 = frag_tr(KD, 136, 32 * wd + 16, 32 * ks, lane);
#pragma unroll
              for (int m = 0; m < 4; ++m) { const bf16x8 a = frag_tr(VS, 136, 64 * we + 16 * m, 32 * ks, lane); nw[m][0] = MFMA16(a, b0, nw[m][0]); nw[m][1] = MFMA16(a, b1, nw[m][1]); } }
#pragma unroll
          for (int m = 0; m < 4; ++m) { S[m][0] = S[m][0] * g128 + nw[m][0]; S[m][1] = S[m][1] * g128 + nw[m][1]; } }
        __syncthreads();
    }
    { float* rp = A.out + O_RP + ((size_t)bh * 256 + db * 128 + 32 * wd + i15) * 512 + eb * 128 + 64 * we + 4 * g;
#pragma unroll
      for (int m = 0; m < 4; ++m) { *(f32x4*)(rp + 16 * m) = S[m][0]; *(f32x4*)(rp + (size_t)16 * 512 + 16 * m) = S[m][1]; } }
}

__device__ __forceinline__ void ret_out_item(const Frame& F, const Args& A, int it) {
    const int bh = it >> 5, c = it & 31, b = bh >> 3, h = bh & 7;
    const int tid = F.tid, lane = F.lane, w = F.wave, g = lane >> 4, i15 = lane & 15;
    const bf16_t* P1 = (const bf16_t*)(A.ws + WS_P1);
    const bf16_t* SPR = (const bf16_t*)(A.ws + WS_SPR);
    bf16_t* RO = (bf16_t*)(A.ws + WS_RO);
    LAS bf16_t* KQ = (LAS bf16_t*)F.lds;
    LAS bf16_t* AM = KQ + 128 * 264;
    LAS bf16_t* VS = AM + 128 * 136;
    LAS float* RS = (LAS float*)(VS + 128 * 136);
    const float l2g = ret_log2_gamma(h);
    const size_t row0 = (size_t)b * SEQ + c * 128;
    { u32x4 kr[8];
      int tq = tid; asm volatile("" : "+v"(tq));
      const bf16_t* kp = P1 + (row0 + (tq >> 5)) * N3 + C_K + h * 256 + 8 * (tq & 31);
#pragma unroll
      for (int i = 0; i < 8; ++i) kr[i] = *(const u32x4*)(kp + (size_t)i * 16 * N3);
#pragma unroll
      for (int i = 0; i < 8; ++i) { const int idx = tid + NTHREADS * i, r = idx >> 5, ch = idx & 31; *(LAS u32x4*)(KQ + r * 264 + 8 * ch) = kr[i]; } }
    bf16x8 aq[8];
    { const bf16_t* qsrc = P1 + (row0 + 16 * w + i15) * N3 + C_Q + h * 256 + 8 * g;
#pragma unroll
      for (int ks = 0; ks < 8; ++ks) aq[ks] = *(const bf16x8*)(qsrc + 32 * ks); }
    __syncthreads();
#pragma unroll 1
    for (int st = 0; st < 8; ++st) {
        f32x4 sa = (f32x4){0.f, 0.f, 0.f, 0.f};
        if (st <= w) {
#pragma unroll
            for (int ks = 0; ks < 8; ++ks) sa = MFMA16(aq[ks], frag_nat(KQ, 264, 16 * st, 32 * ks, lane), sa);
        }
#pragma unroll
        for (int r = 0; r < 4; ++r) { const int t = 16 * w + 4 * g + r, s2 = 16 * st + i15;
            AM[t * 136 + s2] = (bf16_t)f2bf_hw(s2 <= t ? sa[r] * exp2f(l2g * (float)(t - s2)) : 0.f); }
    }
    __syncthreads();
    { u32x4 qr[8];
      int tq = tid; asm volatile("" : "+v"(tq));
      const bf16_t* qp = P1 + (row0 + (tq >> 5)) * N3 + C_Q + h * 256 + 8 * (tq & 31);
#pragma unroll
      for (int i = 0; i < 8; ++i) qr[i] = *(const u32x4*)(qp + (size_t)i * 16 * N3);
#pragma unroll
      for (int i = 0; i < 8; ++i) { const int idx = tid + NTHREADS * i, r = idx >> 5, ch = idx & 31; const float qs = exp2f(l2g * (float)(r + 1)); const u32x4 x = qr[i]; u32x4 o;
          o.x = pk2_hw(bflo(x.x) * qs, bfhi(x.x) * qs); o.y = pk2_hw(bflo(x.y) * qs, bfhi(x.y) * qs); o.z = pk2_hw(bflo(x.z) * qs, bfhi(x.z) * qs); o.w = pk2_hw(bflo(x.w) * qs, bfhi(x.w) * qs);
          *(LAS u32x4*)(KQ + r * 264 + 8 * ch) = o; } }
    const int wt = w >> 2, we = w & 3;
    f32x4 acc[4][4][2];
#pragma unroll
    for (int eq = 0; eq < 4; ++eq)
#pragma unroll
        for (int m = 0; m < 4; ++m) { acc[eq][m][0] = (f32x4){0.f, 0.f, 0.f, 0.f}; acc[eq][m][1] = acc[eq][m][0]; }
    u32x4 vpre[4];
    { int tq = tid; asm volatile("" : "+v"(tq));
      const bf16_t* vp = P1 + (row0 + (tq >> 4)) * N3 + C_V + h * 512 + 8 * (tq & 15);
#pragma unroll
      for (int i = 0; i < 4; ++i) vpre[i] = *(const u32x4*)(vp + (size_t)i * 32 * N3); }
#pragma unroll
    for (int eq = 0; eq < 4; ++eq) {
#pragma unroll
        for (int i = 0; i < 4; ++i) { const int idx = tid + NTHREADS * i, r = idx >> 4, ch = idx & 15; *(LAS u32x4*)(VS + r * 136 + 8 * ch) = vpre[i]; }
        bf16x8 sb[8];
        int ln = lane; asm volatile("" : "+v"(ln));
        const bf16_t* sp = SPR + ((size_t)(bh * 32 + c) * 512 + eq * 128 + 32 * we + (ln & 15)) * 256 + 8 * (ln >> 4);
#pragma unroll
        for (int j = 0; j < 4; ++j) { sb[2 * j] = *(const bf16x8*)(sp + 32 * j); sb[2 * j + 1] = *(const bf16x8*)(sp + 16 * 256 + 32 * j); }
        if (eq < 3) { int tq = tid; asm volatile("" : "+v"(tq));
            const bf16_t* vp = P1 + (row0 + (tq >> 4)) * N3 + C_V + h * 512 + (eq + 1) * 128 + 8 * (tq & 15);
#pragma unroll
            for (int i = 0; i < 4; ++i) vpre[i] = *(const u32x4*)(vp + (size_t)i * 32 * N3); }
        __syncthreads();
#pragma unroll 1
        for (int ks = 0; ks < 2 * (wt + 1); ++ks) { const bf16x8 b0 = frag_tr(VS, 136, 32 * we, 32 * ks, lane), b1 = frag_tr(VS, 136, 32 * we + 16, 32 * ks, lane);
#pragma unroll
            for (int m = 0; m < 4; ++m) { if (32 * ks <= 64 * wt + 16 * m + 15) { const bf16x8 a = frag_nat(AM, 136, 64 * wt + 16 * m, 32 * ks, lane);
                acc[eq][m][0] = MFMA16(a, b0, acc[eq][m][0]); acc[eq][m][1] = MFMA16(a, b1, acc[eq][m][1]); } } }
#pragma unroll 1
        for (int ks = 0; ks < 8; ++ks) {
#pragma unroll
            for (int m = 0; m < 4; ++m) { const bf16x8 a = frag_nat(KQ, 264, 64 * wt + 16 * m, 32 * ks, lane);
                acc[eq][m][0] = MFMA16(a, sb[0], acc[eq][m][0]); acc[eq][m][1] = MFMA16(a, sb[1], acc[eq][m][1]); }
#pragma unroll
            for (int j = 0; j < 6; ++j) sb[j] = sb[j + 2];
            if (ks + 4 < 8) { sb[6] = *(const bf16x8*)(sp + 32 * (ks + 4)); sb[7] = *(const bf16x8*)(sp + 16 * 256 + 32 * (ks + 4)); }
        }
        __syncthreads();
    }
#pragma unroll
    for (int m = 0; m < 4; ++m)
#pragma unroll
        for (int r = 0; r < 4; ++r) { float ss = 0.f;
#pragma unroll
            for (int eq = 0; eq < 4; ++eq) ss += acc[eq][m][0][r] * acc[eq][m][0][r] + acc[eq][m][1][r] * acc[eq][m][1][r];
            ss = red16_sum(ss); if (i15 == 0) RS[we * 128 + 64 * wt + 16 * m + 4 * g + r] = ss; asm volatile("" ::: "memory"); }
    __syncthreads();
    LAS bf16_t* OS = (LAS bf16_t*)F.lds;
    { float rg[4][2];
#pragma unroll
      for (int eq = 0; eq < 4; ++eq) { rg[eq][0] = A.in[I_RTG][eq * 128 + 32 * we + i15]; rg[eq][1] = A.in[I_RTG][eq * 128 + 32 * we + 16 + i15]; }
#pragma unroll
      for (int m = 0; m < 4; ++m)
#pragma unroll
          for (int r = 0; r < 4; ++r) { const int t = 64 * wt + 16 * m + 4 * g + r;
              const float rr = rsqrtf((RS[t] + RS[128 + t] + RS[256 + t] + RS[384 + t]) * (1.f / 512.f) + EPS);
#pragma unroll
              for (int eq = 0; eq < 4; ++eq) { OS[t * 520 + eq * 128 + 32 * we + i15] = (bf16_t)f2bf_hw(acc[eq][m][0][r] * rr * rg[eq][0]); OS[t * 520 + eq * 128 + 32 * we + 16 + i15] = (bf16_t)f2bf_hw(acc[eq][m][1][r] * rr * rg[eq][1]); }
              asm volatile("" ::: "memory"); } }
    int tq2 = tid; asm volatile("" : "+v"(tq2));
    u32x4 gva[16];
#pragma unroll
    for (int i = 0; i < 16; ++i) { const int idx = tq2 + NTHREADS * i, t = idx >> 6, ch = idx & 63; gva[i] = *(const u32x4*)(P1 + (row0 + t) * N3 + C_G + h * 512 + 8 * ch); }
    __syncthreads();
#pragma unroll
    for (int i = 0; i < 16; ++i) { const int idx = tq2 + NTHREADS * i, t = idx >> 6, ch = idx & 63;
        const u32x4 ov = *(const LAS u32x4*)(OS + t * 520 + 8 * ch);
        const u32x4 gv = gva[i];
        u32x4 o;
        o.x = pk2_hw(bflo(ov.x) * bflo(gv.x), bfhi(ov.x) * bfhi(gv.x)); o.y = pk2_hw(bflo(ov.y) * bflo(gv.y), bfhi(ov.y) * bfhi(gv.y));
        o.z = pk2_hw(bflo(ov.z) * bflo(gv.z), bfhi(ov.z) * bfhi(gv.z)); o.w = pk2_hw(bflo(ov.w) * bflo(gv.w), bfhi(ov.w) * bfhi(gv.w));
        *(u32x4*)(RO + (row0 + t) * KO1 + h * 512 + 8 * ch) = o; }
}

#ifndef MK_N_LAUNCHES
#define MK_N_LAUNCHES 1
#endif
constexpr int NPH = 13;
constexpr int RET_S9 = 512;
constexpr int RET_S10 = 1024;
#ifndef PG8_SP2
#define PG8_SP2 true
#endif
#ifndef PG8_ALIGN
#define PG8_ALIGN true
#endif

__global__ void __launch_bounds__(NTHREADS, 2) mega_fwd(Args args) {
    extern __shared__ __attribute__((aligned(16))) unsigned char lds_raw[];
    Frame F;
    F.lds = (LAS unsigned char*)lds_raw + LDS_SCR;
    F.MISC = (volatile LAS unsigned*)((LAS unsigned char*)lds_raw + LDS_MISC);
    F.tid = threadIdx.x; F.lane = F.tid & 63; F.wave = __builtin_amdgcn_readfirstlane(F.tid >> 6);
    F.G = gridDim.x;
    if (F.tid < 64) F.MISC[F.tid] = 0u;
    __syncthreads();
    unsigned* ctl = (unsigned*)(args.ws + WS_CTL);
    XcdBarrier bar; bar.bar = ctl + CW_BAR; bar.x = 0; bar.st = nullptr;
    const int lo = args.ph_lo, hi = args.ph_hi & 255, qmask = (args.ph_hi >> 8) ? (args.ph_hi >> 8) : 255;
    if (hi - lo > 1) bar = xcd_barrier_post(ctl + CW_BAR, F.MISC + 8);
#ifndef PH_MASK
#define PH_MASK 0x1fff
#endif
#define IN(k) (((PH_MASK >> (k)) & 1) && lo <= (k) && (k) < hi)
#define SEAM(k) do { if (IN(k) && IN((k) + 1)) xcd_barrier(bar); } while (0)
    unsigned char* ws = args.ws;

    if (IN(0)) { p1_mods(F, args); __syncthreads(); p0_prologue(F, args); }
    SEAM(0);
    if (IN(1)) { mods_reduce(F, args); } SEAM(1);
    if (IN(2)) { norm_phase(F, args, 0); } SEAM(2);
    if (IN(3)) {
        pg8::Gemm g{(const bf16_t*)(ws + WS_H), (const bf16_t*)(ws + WS_WT1), MROWS, N1P, DM}; pg8::StaticOrder S; S.init(MROWS, N1P, F.G, (int)blockIdx.x);
        EpiP0 E{(bf16_t*)(ws + WS_P0), (float*)(ws + WS_LR)};
        pg8::gemm_phase<EpiP0, pg8::StaticOrder, PG8_ALIGN, PG8_SP2>(F.lds, g, S, E);
    } SEAM(3);
    if (IN(4)) {
        if ((qmask & 1) && (int)blockIdx.x < 64 && F.G >= 64) gla_state_item(F, args, ((int)blockIdx.x & 7) * 8 + ((int)blockIdx.x >> 3));
        else if ((qmask & 1) && F.G < 64) for (int it = blockIdx.x; it < 64; it += F.G) { gla_state_item(F, args, it); __syncthreads(); }
        if (qmask & 2) for (;;) { const int it = next_item(F, ctl + CW_Q0 + 128); if (it >= 128) break; swa_prompt_item(F, args, it); }
        if (qmask & 4) for (;;) { const int it = next_item(F, ctl + CW_Q0 + 192); if (it >= 256) break; swa_sample_item(F, args, it); }
        if (qmask & 8) for (;;) { const int it = next_item(F, ctl + CW_Q0 + 256); if (it >= 512) break; gla_sample_item(F, args, it); }
        if (qmask & 16) tr_queue(F, args, ctl + CW_Q0 + 448);
    } SEAM(4);
    if (IN(5)) {
        for (int it = blockIdx.x; it < 512; it += F.G) { gla_out_item(F, args, it); __syncthreads(); }
    } SEAM(5);
    if (IN(6)) {
        pg8::Gemm g{(const bf16_t*)(ws + WS_MIX), (const bf16_t*)(ws + WS_WT2), TP, DM, DM}; pg8::StaticOrder S; S.init(TP, DM, F.G, (int)blockIdx.x);
        EpiY1 E{args.in[I_XP], (const float*)(ws + WS_MOD0), (bf16_t*)(ws + WS_Y1)};
        pg8::gemm_phase<EpiY1, pg8::StaticOrder, PG8_ALIGN, PG8_SP2>(F.lds, g, S, E);
        mini_gemm_sample<true>(F, (const bf16_t*)(ws + WS_MIX) + (size_t)TP * DM, (const bf16_t*)(ws + WS_WT2), DM, args.in[I_XS], (const float*)(ws + WS_MOD0), ws + WS_Y1);
    } SEAM(6);
    if (IN(7)) { norm_phase(F, args, 1); } SEAM(7);
    if (IN(8)) {
        pg8::Gemm g{(const bf16_t*)(ws + WS_H), (const bf16_t*)(ws + WS_WT3), MROWS, N3, DM}; pg8::StaticOrder S; S.init(MROWS, N3, F.G, (int)blockIdx.x);
        EpiP1 E{(bf16_t*)(ws + WS_P1), (const f32x2*)(ws + WS_ROT)};
        pg8::gemm_phase<EpiP1, pg8::StaticOrder, PG8_ALIGN, PG8_SP2>(F.lds, g, S, E);
        { const int nfull = (MROWS / 256) * (N3 / 256) - 6 * F.G;
          if (nfull >= 0 && nfull < F.G && (int)blockIdx.x >= nfull) wt4_transposes(F, args, nfull);
          else if (nfull < 0 || nfull >= F.G) wt4_transposes(F, args, 0); }
    } SEAM(8);
    if (IN(9)) {
        if ((qmask & 1) && (int)blockIdx.x < 128 && F.G >= 128) { const int x = (int)blockIdx.x & 7, j = (int)blockIdx.x >> 3; ret_state_item(F, args, (2 * x + (j >> 3)) * 8 + (j & 7)); }
        else if ((qmask & 1) && F.G < 128) for (int it = blockIdx.x; it < 128; it += F.G) { ret_state_item(F, args, it); __syncthreads(); }
        if (qmask & 2) for (;;) { const int it = next_item(F, ctl + CW_Q0 + 384); if (it >= RET_S9) break; ret_sample_item(F, args, it); }
    } SEAM(9);
    if (IN(10)) {
        const bool stream_first = (((int)blockIdx.x >> 3) & 1) == 0;
        if (stream_first) { for (int it = RET_S9 + (int)blockIdx.x; it < RET_S10; it += F.G) { ret_sample_item(F, args, it); __syncthreads(); } }
        for (int it = blockIdx.x; it < 512; it += F.G) { ret_out_item(F, args, it); __syncthreads(); }
        if (!stream_first) { for (int it = RET_S9 + (int)blockIdx.x; it < RET_S10; it += F.G) { ret_sample_item(F, args, it); __syncthreads(); } }
    } SEAM(10);
    if (IN(11)) {
        const bool tile_first = (((int)blockIdx.x >> 3) & 1) == 0;
        if (!tile_first) { for (int it = RET_S10 + (int)blockIdx.x; it < 1024; it += F.G) { __syncthreads(); ret_sample_item(F, args, it); } __syncthreads(); }
        { pg8::Gemm g{(const bf16_t*)(ws + WS_RO), (const bf16_t*)(ws + WS_WT4), TP, DM, KO1}; pg8::StaticOrder S; S.init(TP, DM, F.G, (int)blockIdx.x);
          EpiOut E{(const bf16_t*)(ws + WS_Y1), (const float*)(ws + WS_MOD1), args.out + O_Y};
          pg8::gemm_phase<EpiOut, pg8::StaticOrder, PG8_ALIGN, PG8_SP2>(F.lds, g, S, E); }
        if (tile_first) { for (int it = RET_S10 + (int)blockIdx.x; it < 1024; it += F.G) { __syncthreads(); ret_sample_item(F, args, it); } __syncthreads(); }
        static_assert(RET_S10 == 1024, "the sample rows' GEMM4 rides in phase 11 only if no sample-state item is left for this phase");
        __syncthreads();
        mini_gemm_sample<false>(F, (const bf16_t*)(ws + WS_RO) + (size_t)TP * KO1, (const bf16_t*)(ws + WS_WT4), KO1, (const bf16_t*)(ws + WS_Y1) + (size_t)TP * DM, (const float*)(ws + WS_MOD1), args.out + O_Y);
    }
    if (IN(12)) { }
#undef IN
#undef SEAM
}

extern "C" void kernel_launch(void* const* d_in, const int* in_sizes, int n_in, void* d_out, int out_size, void* d_ws, size_t ws_size, hipStream_t stream) {
    static int grid = 0;
    if (grid == 0) {
        if (n_in != N_IN || (size_t)out_size != O_END || ws_size < WS_END) { fprintf(stderr, "kernel_launch: unexpected shapes: n_in %d out %d ws %zu\n", n_in, out_size, ws_size); grid = -1; return; }
        int dev = 0, cus = 0, per_cu = 0;
        if (hipGetDevice(&dev) != hipSuccess || hipDeviceGetAttribute(&cus, hipDeviceAttributeMultiprocessorCount, dev) != hipSuccess) { grid = -1; return; }
        if (hipFuncSetAttribute((const void*)mega_fwd, hipFuncAttributeMaxDynamicSharedMemorySize, LDS_BYTES) != hipSuccess) { fprintf(stderr, "kernel_launch: hipFuncSetAttribute failed\n"); grid = -1; return; }
        if (hipOccupancyMaxActiveBlocksPerMultiprocessor(&per_cu, (const void*)mega_fwd, NTHREADS, LDS_BYTES) != hipSuccess || per_cu < 1) { fprintf(stderr, "kernel_launch: occupancy query says %d\n", per_cu); per_cu = 1; }
        (void)hipGetLastError();
        grid = cus;
    }
    if (grid < 0) return;
    (void)hipMemsetAsync((char*)d_ws + WS_CTL, 0, CTL_ZERO_BYTES, stream);
    Args a{};
    for (int i = 0; i < N_IN; ++i) a.in[i] = (const float*)d_in[i];
    a.out = (float*)d_out; a.ws = (unsigned char*)d_ws;
#if MK_N_LAUNCHES == 1
    a.ph_lo = 0; a.ph_hi = NPH;
    { void* kargs[] = {&a};
      hipError_t e = hipLaunchCooperativeKernel((const void*)mega_fwd, dim3(grid), dim3(NTHREADS), kargs, LDS_BYTES, stream);
      if (e != hipSuccess) fprintf(stderr, "kernel_launch: cooperative launch failed: %s (grid %d)\n", hipGetErrorString(e), grid); }
#ifdef PROBE_PHASE
#ifndef PROBE_QMASK
#define PROBE_QMASK 0
#endif
    (void)hipMemsetAsync((char*)d_ws + WS_CTL, 0, CTL_ZERO_BYTES, stream);
    a.ph_lo = PROBE_PHASE; a.ph_hi = (PROBE_PHASE + 1) | (PROBE_QMASK << 8);
    hipLaunchKernelGGL(mega_fwd, dim3(grid), dim3(NTHREADS), LDS_BYTES, stream, a);
#endif
#else
    for (int p = 0; p < NPH; ++p) { a.ph_lo = p; a.ph_hi = p + 1;
        hipLaunchKernelGGL(mega_fwd, dim3(grid), dim3(NTHREADS), LDS_BYTES, stream, a);
        hipError_t e = hipPeekAtLastError(); if (e != hipSuccess) { fprintf(stderr, "kernel_launch: launch %d failed: %s\n", p, hipGetErrorName(e)); break; } }
#endif
}
```

```cpp
#include <hip/hip_runtime.h>
#include <cstdio>
#include <cstdint>

#define LAS __attribute__((address_space(3)))
#define GAS __attribute__((address_space(1)))
typedef unsigned short bf16_t;
typedef short bf16x8 __attribute__((ext_vector_type(8)));
typedef short s16x4 __attribute__((ext_vector_type(4)));
typedef float f32x4 __attribute__((ext_vector_type(4)));
typedef float f32x2 __attribute__((ext_vector_type(2)));
typedef unsigned u32x4 __attribute__((ext_vector_type(4)));
typedef unsigned u32x2 __attribute__((ext_vector_type(2)));

namespace pg8 {
constexpr int BM = 256, BK = 64, HALF = 128, HTB = HALF * BK * 2  , STAGE_BYTES = 8 * HTB, NXCD = 8, WGM = 8;

__host__ __device__ __forceinline__ int lds_byte(int r, int c) { const int st = (r >> 4) * 2 + (c >> 5), rr = r & 15, cc = c & 31, ob = rr * 64 + cc * 2; return st * 1024 + (ob ^ (((ob >> 9) & 1) << 5)); }
__host__ __device__ __forceinline__ void stage_rc(int b, int& R, int& C) { const int st = b / 1024, sb = b % 1024, swz = sb ^ (((sb >> 9) & 1) << 5); R = (st >> 1) * 16 + swz / 64; C = (st & 1) * 32 + (swz % 64) / 2; }
__host__ __device__ __forceinline__ int perm32(int rho) { const int n = rho >> 4, i = rho & 15; return 8 * (i >> 2) + 4 * n + (i & 3); }

struct Unit { int pm, pn; };
struct Gemm { const bf16_t* A; const bf16_t* Bt; int M, N, K; };

struct StaticOrder {
    int nM, nN, nwg, G, c;
    __host__ __device__ void init(int M, int N, int G_, int c_) { nM = M / BM; nN = N / BM; nwg = nM * nN; G = G_; c = c_; }
    __host__ __device__ bool next(int i, Unit& u) const {
        const long L = (long)i * G + c; if (L >= nwg) return false;
        int wgid = (int)L; { const int q = nwg / NXCD, r = nwg % NXCD, xcd = wgid % NXCD, off = wgid / NXCD; wgid = (xcd < r ? xcd * (q + 1) : r * (q + 1) + (xcd - r) * q) + off; }
        const int nig = WGM * nN, gid = wgid / nig, fm = gid * WGM, gsz = (nM - fm) < WGM ? (nM - fm) : WGM;
        u.pm = fm + ((wgid % nig) % gsz); u.pn = (wgid % nig) / gsz; return true;
    }
    __device__ __forceinline__ void a_ready(const Unit&) const {}
    __device__ __forceinline__ void done(const Unit&) const {}
};

__device__ __forceinline__ unsigned cvt_pk_bf16(float lo, float hi) { unsigned r; asm volatile("v_cvt_pk_bf16_f32 %0, %1, %2" : "=v"(r) : "v"(lo), "v"(hi)); return r; }

template <class Epi, class Sched, bool ALIGN_EPI = false, bool SP2 = false>
__device__ __forceinline__ void gemm_phase(LAS unsigned char* lds, const Gemm g, const Sched& S, const Epi& E) {
    const int tid = threadIdx.x, wid = __builtin_amdgcn_readfirstlane(tid >> 6), lane = tid & 63, wr = wid >> 2, wc = wid & 3, fr = lane & 15, fq = lane >> 4;
    const int K = g.K, nt = K / BK;
    unsigned voffA[2], voffB[2];
#pragma unroll
    for (int i = 0; i < 2; ++i) { int R, C; stage_rc(tid * 16 + i * 8192, R, C); const int Rb = Epi::PERM ? ((R & ~31) + perm32(R & 31)) : R;
        voffA[i] = (unsigned)(R * K + C) * 2u; voffB[i] = (unsigned)(Rb * K + C) * 2u; }
    const size_t kstep = (size_t)(BK * 2);
    const size_t hstep = (size_t)HALF * K * 2;
    const size_t tstep = 2 * hstep;
    const unsigned ldsw = (unsigned)wid * 1024u;
    const int aoff = lds_byte(wr * 64 + fr, fq * 8), boff = lds_byte(wc * 32 + fr, fq * 8);
#define PG8_SA(b, h) (((b) * 2 + (h)) * HTB)
#define PG8_SB(b, h) ((4 + (b) * 2 + (h)) * HTB)
#define PG8_STAGE(bufoff, gbase, voff) do { _Pragma("unroll") for (int _i = 0; _i < 2; ++_i) \
        __builtin_amdgcn_global_load_lds((const unsigned*)((const char*)(gbase) + (voff)[_i]), (LAS unsigned*)(lds + (bufoff) + ldsw + _i * 8192), 16, 0, 0); } while (0)
#define PG8_LDA(dst, b, h) do { _Pragma("unroll") for (int m = 0; m < 4; ++m) _Pragma("unroll") for (int k = 0; k < 2; ++k) dst[m][k] = *(const LAS bf16x8*)(lds + PG8_SA(b, h) + aoff + m * 2048 + k * 1024); } while (0)
#define PG8_LDB(dst, b, h) do { _Pragma("unroll") for (int n = 0; n < 2; ++n) _Pragma("unroll") for (int k = 0; k < 2; ++k) dst[n][k] = *(const LAS bf16x8*)(lds + PG8_SB(b, h) + boff + n * 2048 + k * 1024); } while (0)
#define PG8_MMA(ai, bj, At, Bt) do { __builtin_amdgcn_s_setprio(1); _Pragma("unroll") for (int m = 0; m < 4; ++m) _Pragma("unroll") for (int n = 0; n < 2; ++n) _Pragma("unroll") for (int k = 0; k < 2; ++k) \
        acc[ai][bj][m][n] = __builtin_amdgcn_mfma_f32_16x16x32_bf16(Bt[n][k], At[m][k], acc[ai][bj][m][n], 0, 0, 0); __builtin_amdgcn_s_setprio(0); } while (0)
#define PG8_WAIT_V(n) asm volatile("s_waitcnt vmcnt(" #n ")" ::: "memory")
#define PG8_WAIT_L(n) asm volatile("s_waitcnt lgkmcnt(" #n ")" ::: "memory")
#define PG8_BAR __builtin_amdgcn_s_barrier()
#define PG8_SCHED __builtin_amdgcn_sched_barrier(0)
    Unit cur, nxt; int ui = 0;
    if (!S.next(0, cur)) return;
    f32x4 acc[2][2][4][2];
#pragma unroll
    for (int a = 0; a < 2; ++a)
#pragma unroll
        for (int b = 0; b < 2; ++b)
#pragma unroll
            for (int m = 0; m < 4; ++m)
#pragma unroll
                for (int n = 0; n < 2; ++n) acc[a][b][m][n] = (f32x4){0.f, 0.f, 0.f, 0.f};
    bf16x8 At[4][2], B0[2][2], B1[2][2];
    const char* cA = (const char*)g.A + (size_t)cur.pm * tstep; const char* cB = (const char*)g.Bt + (size_t)cur.pn * tstep;
    S.a_ready(cur);
    if constexpr (SP2) {
        PG8_STAGE(PG8_SB(0, 0), cB, voffB); PG8_STAGE(PG8_SB(0, 1), cB + hstep, voffB); PG8_STAGE(PG8_SA(0, 0), cA, voffA); PG8_STAGE(PG8_SA(0, 1), cA + hstep, voffA);
        if (wr == 1) PG8_BAR;
        PG8_WAIT_V(2); PG8_BAR;
        PG8_STAGE(PG8_SB(1, 0), cB + kstep, voffB); PG8_STAGE(PG8_SA(1, 0), cA + kstep, voffA); PG8_STAGE(PG8_SB(1, 1), cB + hstep + kstep, voffB);
        PG8_WAIT_V(6); PG8_BAR;
    } else {
        PG8_STAGE(PG8_SB(0, 0), cB, voffB); PG8_STAGE(PG8_SA(0, 0), cA, voffA); PG8_STAGE(PG8_SB(0, 1), cB + hstep, voffB); PG8_STAGE(PG8_SA(0, 1), cA + hstep, voffA);
        if (wr == 1) PG8_BAR;
        PG8_WAIT_V(4); PG8_BAR;
        PG8_STAGE(PG8_SB(1, 0), cB + kstep, voffB); PG8_STAGE(PG8_SA(1, 0), cA + kstep, voffA); PG8_STAGE(PG8_SB(1, 1), cB + hstep + kstep, voffB);
        PG8_WAIT_V(6); PG8_BAR;
    }
    for (;;) {
        const bool has_next = S.next(ui + 1, nxt);
        const char* nA = has_next ? (const char*)g.A + (size_t)nxt.pm * tstep : cA; const char* nB = has_next ? (const char*)g.Bt + (size_t)nxt.pn * tstep : cB;
        for (int t = 0; t < nt; t += 2) {
            const bool last = (t == nt - 2);
            const char* a1 = cA + (size_t)(t + 1) * kstep;
            const char* a2 = last ? nA : cA + (size_t)(t + 2) * kstep; const char* b2 = last ? nB : cB + (size_t)(t + 2) * kstep;
            const char* a3 = a2 + kstep; const char* b3 = b2 + kstep;
            if (last && has_next) S.a_ready(nxt);
            if constexpr (SP2) {
            PG8_LDB(B0, 0, 0); PG8_LDB(B1, 0, 1); PG8_SCHED; PG8_LDA(At, 0, 0); PG8_STAGE(PG8_SA(1, 1), a1 + hstep, voffA);
            PG8_WAIT_V(8); PG8_WAIT_L(0); PG8_BAR; PG8_MMA(0, 0, At, B0); PG8_MMA(0, 1, At, B1); PG8_BAR; PG8_SCHED;
            PG8_LDA(At, 0, 1); PG8_STAGE(PG8_SB(0, 0), b2, voffB); PG8_STAGE(PG8_SB(0, 1), b2 + hstep, voffB); PG8_STAGE(PG8_SA(0, 0), a2, voffA);
            PG8_WAIT_V(8); PG8_WAIT_L(0); PG8_BAR; PG8_MMA(1, 0, At, B0); PG8_MMA(1, 1, At, B1); PG8_BAR; PG8_SCHED;
            PG8_LDB(B0, 1, 0); PG8_LDB(B1, 1, 1); PG8_SCHED; PG8_LDA(At, 1, 0); PG8_STAGE(PG8_SA(0, 1), a2 + hstep, voffA);
            PG8_WAIT_V(8); PG8_WAIT_L(0); PG8_BAR; PG8_MMA(0, 0, At, B0); PG8_MMA(0, 1, At, B1); PG8_BAR; PG8_SCHED;
            PG8_LDA(At, 1, 1); PG8_STAGE(PG8_SB(1, 0), b3, voffB); PG8_STAGE(PG8_SB(1, 1), b3 + hstep, voffB); PG8_STAGE(PG8_SA(1, 0), a3, voffA);
            PG8_WAIT_V(8); PG8_WAIT_L(0); PG8_BAR; PG8_MMA(1, 0, At, B0); PG8_MMA(1, 1, At, B1); PG8_BAR; PG8_SCHED;
            } else {
            PG8_LDB(B0, 0, 0); PG8_SCHED; PG8_LDA(At, 0, 0); PG8_STAGE(PG8_SA(1, 1), a1 + hstep, voffA);
            PG8_WAIT_L(8); PG8_BAR; PG8_WAIT_L(0); PG8_MMA(0, 0, At, B0); PG8_BAR; PG8_SCHED;
            PG8_LDB(B1, 0, 1); PG8_STAGE(PG8_SB(0, 0), b2, voffB);
            PG8_BAR; PG8_WAIT_L(0); PG8_MMA(0, 1, At, B1); PG8_BAR;
            PG8_LDA(At, 0, 1); PG8_STAGE(PG8_SA(0, 0), a2, voffA);
            PG8_BAR; PG8_WAIT_L(0); PG8_MMA(1, 0, At, B0); PG8_BAR; PG8_SCHED;
            PG8_STAGE(PG8_SB(0, 1), b2 + hstep, voffB);
            PG8_WAIT_V(6); PG8_BAR; PG8_MMA(1, 1, At, B1); PG8_BAR;
            PG8_LDB(B0, 1, 0); PG8_SCHED; PG8_LDA(At, 1, 0); PG8_STAGE(PG8_SA(0, 1), a2 + hstep, voffA);
            PG8_WAIT_L(8); PG8_BAR; PG8_WAIT_L(0); PG8_MMA(0, 0, At, B0); PG8_BAR; PG8_SCHED;
            PG8_LDB(B1, 1, 1); PG8_STAGE(PG8_SB(1, 0), b3, voffB);
            PG8_BAR; PG8_WAIT_L(0); PG8_MMA(0, 1, At, B1); PG8_BAR;
            PG8_LDA(At, 1, 1); PG8_STAGE(PG8_SA(1, 0), a3, voffA);
            PG8_BAR; PG8_WAIT_L(0); PG8_MMA(1, 0, At, B0); PG8_BAR; PG8_SCHED;
            PG8_STAGE(PG8_SB(1, 1), b3 + hstep, voffB);
            PG8_WAIT_V(6); PG8_BAR; PG8_MMA(1, 1, At, B1); PG8_BAR;
            }
        }
        if constexpr (ALIGN_EPI) { if (wr == 0) PG8_BAR; }
        E(acc, cur, wr, wc, fr, fq); S.done(cur);
        if (!has_next) break;
#pragma unroll
        for (int a = 0; a < 2; ++a)
#pragma unroll
            for (int b = 0; b < 2; ++b)
#pragma unroll
                for (int m = 0; m < 4; ++m)
#pragma unroll
                    for (int n = 0; n < 2; ++n) acc[a][b][m][n] = (f32x4){0.f, 0.f, 0.f, 0.f};
        cur = nxt; cA = nA; cB = nB; ++ui;
        if constexpr (ALIGN_EPI) { if (wr == 1) PG8_BAR; }
    }
    PG8_WAIT_V(0);
    if constexpr (!ALIGN_EPI) { if (wr == 0) PG8_BAR; }
    PG8_BAR;
#undef PG8_SA
#undef PG8_SB
#undef PG8_STAGE
#undef PG8_LDA
#undef PG8_LDB
#undef PG8_MMA
#undef PG8_WAIT_V
#undef PG8_WAIT_L
#undef PG8_BAR
#undef PG8_SCHED
}
}

constexpr int NWAVES = 8, NTHREADS = 512;
constexpr int DM = 2048, SEQ = 4096, TP = 8192, TS = 512, MROWS = TP + TS;
constexpr int NBD = 128;
constexpr int N1 = 5376, N1P = 5632, NIN0 = 5392, N3 = 12288, KO1 = 4096;
constexpr int C_QA = 0, C_KA = 1024, C_VA = 1152, C_GA = 1280, C_QB = 2304, C_KB = 2816, C_VB = 3328, C_GB = 4352;
constexpr int C_Q = 0, C_K = 2048, C_V = 4096, C_G = 8192;
constexpr float EPS = 1e-6f;
enum { I_XP = 0, I_XS, I_CK, I_CV, I_SG, I_SR, I_CP, I_CS, I_RB, I_AWE, I_ABE, I_NGE, I_WIE, I_WLR, I_BLR, I_QNG, I_KNG, I_SNK, I_GLG, I_WOE, I_AWO, I_ABO, I_NGO, I_WIO, I_RTG, I_WOO, N_IN };
constexpr size_t O_Y = 0, O_KP = 17825792, O_VP = 17858560, O_GP = 17891328, O_RP = 18153472, O_KS = 20250624, O_VS = 22347776, O_GS = 24444928, O_RS = 41222144, O_END = 175439872;

constexpr size_t MiB = 1u << 20;
constexpr size_t WS_CTL = 0, CTL_ZERO_BYTES = 65536;
constexpr size_t WS_SC = 1 * MiB, WS_MOD0 = 2 * MiB, WS_MOD1 = 6 * MiB, WS_ROT = 10 * MiB, WS_LR = 15 * MiB;
constexpr size_t WS_WT1 = 16 * MiB, WS_WT2 = 38 * MiB, WS_WT3 = 46 * MiB, WS_WT4 = 94 * MiB;
constexpr size_t WS_H = 110 * MiB, WS_P0 = 144 * MiB, WS_MIX = 234 * MiB, WS_Y1 = 268 * MiB, WS_P1 = 336 * MiB, WS_RO = 540 * MiB, WS_SPG = 608 * MiB, WS_SPR = 640 * MiB, WS_END = 768 * MiB;
constexpr int CW_BAR = 1024;
constexpr int CW_Q0 = 8192;

constexpr int LDS_MISC = 0;
constexpr int LDS_SCR = 256;
constexpr int LDS_BYTES = 147456;
constexpr int LDS_SCR_BYTES = LDS_BYTES - LDS_SCR;

#define LDS_WAIT() asm volatile("s_waitcnt lgkmcnt(0)" ::: "memory")
#define VM_WAIT() asm volatile("s_waitcnt vmcnt(0)" ::: "memory")
typedef __bf16 bf16n2 __attribute__((ext_vector_type(2)));
__device__ __forceinline__ unsigned f2bf_hw(float f) { return (unsigned)__builtin_bit_cast(unsigned short, (__bf16)f); }
__device__ __forceinline__ unsigned pk2_hw(float lo, float hi) { const f32x2 v = {lo, hi}; return __builtin_bit_cast(unsigned, __builtin_convertvector(v, bf16n2)); }
__device__ __forceinline__ unsigned f2bf(float f) { unsigned u = __builtin_bit_cast(unsigned, f); return (u + 0x7fffu + ((u >> 16) & 1u)) >> 16; }
__device__ __forceinline__ unsigned pk2(float lo, float hi) { return f2bf(lo) | (f2bf(hi) << 16); }
__device__ __forceinline__ float bf2f(bf16_t b) { return __builtin_bit_cast(float, (unsigned)b << 16); }
__device__ __forceinline__ float bflo(unsigned w) { return __builtin_bit_cast(float, w << 16); }
__device__ __forceinline__ float bfhi(unsigned w) { return __builtin_bit_cast(float, w & 0xffff0000u); }
__device__ __forceinline__ float silu_f(float x) { return x * __builtin_amdgcn_rcpf(1.f + __expf(-x)); }
__device__ __forceinline__ float logsig_f(float z) { return fminf(z, 0.f) - __logf(1.f + __expf(-fabsf(z))); }
__device__ __forceinline__ float wave_sum(float v) {
#pragma unroll
    for (int o = 1; o < 64; o <<= 1) v += __shfl_xor(v, o);
    return v;
}
__device__ __forceinline__ float wave_incl_scan(float v) {
#define WIS_DPP(x, ctrl, rmask) __builtin_bit_cast(float, __builtin_amdgcn_update_dpp(0, __builtin_bit_cast(int, (x)), (ctrl), (rmask), 0xf, false))
    v += WIS_DPP(v, 0x111, 0xf);
    v += WIS_DPP(v, 0x112, 0xf);
    v += WIS_DPP(v, 0x114, 0xf);
    v += WIS_DPP(v, 0x118, 0xf);
    v += WIS_DPP(v, 0x142, 0xa);
    v += WIS_DPP(v, 0x143, 0xc);
#undef WIS_DPP
    return v;
}
__device__ __forceinline__ float red16_sum(float v) { v += __shfl_xor(v, 1); v += __shfl_xor(v, 2); v += __shfl_xor(v, 4); v += __shfl_xor(v, 8); return v; }
__device__ __forceinline__ float red16_max(float v) { v = fmaxf(v, __shfl_xor(v, 1)); v = fmaxf(v, __shfl_xor(v, 2)); v = fmaxf(v, __shfl_xor(v, 4)); v = fmaxf(v, __shfl_xor(v, 8)); return v; }

__device__ __forceinline__ bf16x8 frag_nat(const LAS bf16_t* base, int pitch, int x0, int k0, int lane) {
    return *(const LAS bf16x8*)(base + (x0 + (lane & 15)) * pitch + k0 + 8 * (lane >> 4));
}
__device__ __forceinline__ bf16x8 frag_tr(const LAS bf16_t* base, int pitch, int x0, int k0, int lane) {
    const int g = lane >> 4, i = lane & 15;
    const LAS bf16_t* p = base + (k0 + 8 * g + (i >> 2)) * pitch + x0 + 4 * (i & 3);
    const s16x4 lo = __builtin_amdgcn_ds_read_tr16_b64_v4i16((LAS s16x4*)p);
    const s16x4 hi = __builtin_amdgcn_ds_read_tr16_b64_v4i16((LAS s16x4*)(p + 4 * pitch));
    return (bf16x8){lo[0], lo[1], lo[2], lo[3], hi[0], hi[1], hi[2], hi[3]};
}
#define MFMA16(a, b, c) __builtin_amdgcn_mfma_f32_16x16x32_bf16((a), (b), (c), 0, 0, 0)

#define XB_TMO      128
#define XB_XCNT(j)  (256  + 64 * (j))
#define XB_XSUB(j)  (1280 + 64 * (j))
#define XB_XGEN(j)  (2304 + 64 * (j))
#define XB_TOP      3328
#define XB_TOPGEN   3392
#define XCD_BAR_WORDS 3456
#define XB_SPIN_CAP (1u << 20)
__device__ __forceinline__ unsigned xb_ld(unsigned* p)              { return __hip_atomic_load(p, __ATOMIC_RELAXED, __HIP_MEMORY_SCOPE_AGENT); }
__device__ __forceinline__ unsigned xb_add(unsigned* p, unsigned v) { return __hip_atomic_fetch_add(p, v, __ATOMIC_RELAXED, __HIP_MEMORY_SCOPE_AGENT); }
__device__ __forceinline__ unsigned xb_xcc_id() { return (unsigned)__builtin_amdgcn_s_getreg((3 << 11) | 20) & 0xFu; }
#define XB_SPIN(cond, bar) do { unsigned _sp = 0; while (cond) { __builtin_amdgcn_s_sleep(1); \
    if ((++_sp & 255u) == 0u) { if (xb_ld(&(bar)[XB_TMO])) break; if (_sp > XB_SPIN_CAP) { atomicAdd(&(bar)[XB_TMO], 1u); break; } } } } while (0)
struct XcdBarrier { unsigned* bar; unsigned x; volatile LAS unsigned* st; };
__device__ __forceinline__ XcdBarrier xcd_barrier_post(unsigned* bar, volatile LAS unsigned* st) {
    XcdBarrier b; b.bar = bar; b.x = xb_xcc_id(); b.st = st;
    if (threadIdx.x == 0) (void)xb_add(&bar[XB_XCNT(b.x)], 1u);
    return b;
}
__device__ __forceinline__ void xcd_barrier_complete(unsigned* bar, unsigned x, unsigned& nloc, unsigned& nx) {
    const unsigned G = gridDim.x * gridDim.y * gridDim.z;
    unsigned sum, cnt, mine, sp = 0u;
    for (;;) {
        sum = 0u; cnt = 0u; mine = 0u;
#pragma unroll
        for (unsigned j = 0; j < 16; ++j) { const unsigned c = xb_ld(&bar[XB_XCNT(j)]); sum += c; cnt += (c > 0u) ? 1u : 0u; mine = (j == x) ? c : mine; }
        if (sum == G) break;
        __builtin_amdgcn_s_sleep(1);
        if ((++sp & 255u) == 0u) { if (xb_ld(&bar[XB_TMO])) break; if (sp > XB_SPIN_CAP) { atomicAdd(&bar[XB_TMO], 1u); break; } }
    }
    nloc = mine > 0u ? mine : 1u; nx = cnt > 0u ? cnt : 1u;
}
__device__ __forceinline__ void xcd_barrier(const XcdBarrier& b) {
    asm volatile("s_waitcnt vmcnt(0)" ::: "memory");
    __syncthreads();
    if (threadIdx.x == 0) {
        unsigned* bar = b.bar;
        __builtin_amdgcn_s_waitcnt(0);
        unsigned nloc = b.st[0], nx = b.st[1];
        if (nloc == 0u) { xcd_barrier_complete(bar, b.x, nloc, nx); b.st[0] = nloc; b.st[1] = nx; }
        const unsigned old = xb_add(&bar[XB_XSUB(b.x)], 1u);
        const unsigned gen = old / nloc;
        if (old + 1u == (gen + 1u) * nloc) {
            __builtin_amdgcn_fence(__ATOMIC_RELEASE, "agent");
            asm volatile("s_waitcnt vmcnt(0)" ::: "memory");
            const unsigned og = xb_add(&bar[XB_TOP], 1u);
            const unsigned tg = og / nx;
            if (og + 1u == (tg + 1u) * nx) xb_add(&bar[XB_TOPGEN], 1u);
            else XB_SPIN(xb_ld(&bar[XB_TOPGEN]) == tg, bar);
            __builtin_amdgcn_fence(__ATOMIC_ACQUIRE, "agent");
            xb_add(&bar[XB_XGEN(b.x)], 1u);
            asm volatile("s_waitcnt vmcnt(0)" ::: "memory");
        } else {
            XB_SPIN(xb_ld(&bar[XB_XGEN(b.x)]) == gen, bar);
            __builtin_amdgcn_fence(__ATOMIC_ACQUIRE, "agent");
            asm volatile("s_waitcnt vmcnt(0)" ::: "memory");
        }
    }
    __syncthreads();
}

struct Args { const float* in[N_IN]; float* out; unsigned char* ws; int ph_lo, ph_hi; };
struct Frame {
    LAS unsigned char* lds;
    volatile LAS unsigned* MISC;
    int tid, lane, wave, G;
};
__device__ __forceinline__ int next_item(const Frame& F, unsigned* head) {
    __syncthreads();
    if (F.tid == 0) F.MISC[4] = __hip_atomic_fetch_add(head, 1u, __ATOMIC_RELAXED, __HIP_MEMORY_SCOPE_AGENT);
    __syncthreads();
    return (int)F.MISC[4];
}

struct TrItem { const float* src; bf16_t* dst; int ldw, K; bool ok; };
__device__ __forceinline__ TrItem tr_desc(const float* W, int K, int ldw, int ncol_valid, bf16_t* WT, int kb, int nb, int lane) {
    const int k0 = 64 * kb, n0 = 64 * nb, n4 = n0 + 4 * (lane & 15);
    TrItem d; d.src = W + (size_t)(k0 + (lane >> 4)) * ldw + (n4 < ncol_valid ? n4 : 0)  ; d.dst = WT + (size_t)(n0 + (lane >> 3)) * K + k0 + 8 * (lane & 7); d.ldw = ldw; d.K = K; d.ok = n4 < ncol_valid; return d;
}
__device__ __forceinline__ void tr_load(const TrItem& d, f32x4 (&v)[16]) {
#pragma unroll
    for (int i = 0; i < 16; ++i) v[i] = __builtin_nontemporal_load((const f32x4*)(d.src + (size_t)(4 * i) * d.ldw));
}
__device__ __forceinline__ void tr_finish(const TrItem& d, const f32x4 (&v)[16], LAS float* scr, int lane) {
    const int kr = lane >> 4;
    const float keep = d.ok ? 1.f : 0.f;
#pragma unroll
    for (int i = 0; i < 16; ++i) { LAS float* t = scr + (kr + 4 * i) * 65 + 4 * (lane & 15); t[0] = v[i].x * keep; t[1] = v[i].y * keep; t[2] = v[i].z * keep; t[3] = v[i].w * keep; }
    LDS_WAIT(); asm volatile("" ::: "memory");
    const int c = lane & 7;
#pragma unroll
    for (int j = 0; j < 8; ++j) { const int n = (lane >> 3) + 8 * j; const LAS float* s = scr + (8 * c) * 65 + n;
        u32x4 o; o.x = pk2_hw(s[0 * 65], s[1 * 65]); o.y = pk2_hw(s[2 * 65], s[3 * 65]); o.z = pk2_hw(s[4 * 65], s[5 * 65]); o.w = pk2_hw(s[6 * 65], s[7 * 65]);
        *(u32x4*)(d.dst + (size_t)(8 * j) * d.K) = o; }
    LDS_WAIT(); asm volatile("" ::: "memory");
}
__device__ __forceinline__ TrItem p0_tr_desc(const Args& A, int it, int lane) {
    constexpr int I1 = 32 * 85, I2 = 32 * 32;
    unsigned char* ws = A.ws;
    if (it < I1) return tr_desc(A.in[I_WIE], DM, NIN0, NIN0, (bf16_t*)(ws + WS_WT1), it / 85, it % 85, lane);
    it -= I1;
    if (it < I2) return tr_desc(A.in[I_WOE], DM, DM, DM, (bf16_t*)(ws + WS_WT2), it / 32, it % 32, lane);
    it -= I2;
    return tr_desc(A.in[I_WIO], DM, N3, N3, (bf16_t*)(ws + WS_WT3), it / 192, it % 192, lane);
}
__device__ __forceinline__ void p0_prologue(const Frame& F, const Args& A) {
    unsigned char* ws = A.ws;
    const int gtid = blockIdx.x * NTHREADS + F.tid, NT = F.G * NTHREADS;
    const int gw = blockIdx.x * NWAVES + F.wave, NGW = F.G * NWAVES;
    { f32x2* ROT = (f32x2*)(ws + WS_ROT);
      for (int idx = gtid; idx < 4100 * 128; idx += NT) { const int pi = idx >> 7, d = idx & 127;
          const float pos = (float)(pi < 4096 ? pi : 8192 + (pi - 4096));
          const float inv = powf(10000.f, -(float)d * (1.f / 128.f));
          const double rev = (double)pos * (double)inv * 0.15915494309189535;
          const float fr = (float)(rev - __builtin_floor(rev));
          ROT[idx] = (f32x2){__builtin_amdgcn_cosf(fr), __builtin_amdgcn_sinf(fr)}; } }
    { u32x4* z = (u32x4*)((bf16_t*)(ws + WS_WT1) + (size_t)5440 * DM);
      for (int idx = gtid; idx < 192 * 256; idx += NT) z[idx] = (u32x4){0u, 0u, 0u, 0u}; }
    LAS float* scr = (LAS float*)(F.lds + F.wave * 16640);
    constexpr int NIT = 32 * 85;
    f32x4 va[16], vb[16]; TrItem da, db;
    int it = gw;
    if (it < NIT) { da = p0_tr_desc(A, it, F.lane); tr_load(da, va); }
#pragma unroll 1
    while (it < NIT) {
        const int it1 = it + NGW, it2 = it + 2 * NGW;
        if (it1 < NIT) { db = p0_tr_desc(A, it1, F.lane); tr_load(db, vb); }
        tr_finish(da, va, scr, F.lane);
        if (it1 >= NIT) break;
        if (it2 < NIT) { da = p0_tr_desc(A, it2, F.lane); tr_load(da, va); }
        tr_finish(db, vb, scr, F.lane);
        it = it2;
    }
}
constexpr int TRQ_TICKETS = (32 * 32 + 32 * 192) / 16;
__device__ __forceinline__ void tr_queue(const Frame& F, const Args& A, unsigned* head) {
    LAS float* scr = (LAS float*)(F.lds + F.wave * 16640);
    f32x4 va[16], vb[16];
    for (;;) { const int t = next_item(F, head); if (t >= TRQ_TICKETS) break;
        const int i0 = 32 * 85 + t * 16 + F.wave;
        const TrItem da = p0_tr_desc(A, i0, F.lane); tr_load(da, va);
        const TrItem db = p0_tr_desc(A, i0 + 8, F.lane); tr_load(db, vb);
        tr_finish(da, va, scr, F.lane); tr_finish(db, vb, scr, F.lane); }
}
__device__ __forceinline__ void wt4_transposes(const Frame& F, const Args& A, int blk0) {
    LAS float* scr = (LAS float*)(F.lds + F.wave * 16640);
    const int nw = (F.G - blk0) * NWAVES;
    bf16_t* WT4 = (bf16_t*)(A.ws + WS_WT4);
    f32x4 va[16], vb[16]; TrItem da, db;
    int it = ((int)blockIdx.x - blk0) * NWAVES + F.wave;
    if (it < 64 * 32) { da = tr_desc(A.in[I_WOO], KO1, DM, DM, WT4, it / 32, it % 32, F.lane); tr_load(da, va); }
#pragma unroll 1
    while (it < 64 * 32) {
        const int it1 = it + nw, it2 = it + 2 * nw;
        if (it1 < 64 * 32) { db = tr_desc(A.in[I_WOO], KO1, DM, DM, WT4, it1 / 32, it1 % 32, F.lane); tr_load(db, vb); }
        tr_finish(da, va, scr, F.lane);
        if (it1 >= 64 * 32) break;
        if (it2 < 64 * 32) { da = tr_desc(A.in[I_WOO], KO1, DM, DM, WT4, it2 / 32, it2 % 32, F.lane); tr_load(da, va); }
        tr_finish(db, vb, scr, F.lane);
        it = it2;
    }
}

__device__ __forceinline__ void p1_mods(const Frame& F, const Args& A) {
    LAS bf16_t* tile = (LAS bf16_t*)F.lds;
    LAS bf16_t* scs = tile + 256 * 136;
    const int lane = F.lane, g = lane >> 4, i = lane & 15, w = F.wave, tid = F.tid;
    const int k8 = (int)blockIdx.x & 7, kb = k8 * 256;
    {
        f32x4 cv[9][2];
#pragma unroll
        for (int j = 0; j < 9; ++j) { const int idx = tid + NTHREADS * j, r = idx >> 5, ch = idx & 31, rc = r < 130 ? r : 129;
            const float* cp = (rc < 2 ? A.in[I_CP] + (size_t)rc * DM : A.in[I_CS] + (size_t)(rc - 2) * DM) + kb + 8 * ch; cv[j][0] = *(const f32x4*)cp; cv[j][1] = *(const f32x4*)(cp + 4); }
#pragma unroll
        for (int j = 0; j < 9; ++j) { const int idx = tid + NTHREADS * j, r = idx >> 5, ch = idx & 31; const f32x4 v0 = cv[j][0], v1 = cv[j][1];
            u32x4 o; o.x = pk2_hw(silu_f(v0.x), silu_f(v0.y)); o.y = pk2_hw(silu_f(v0.z), silu_f(v0.w)); o.z = pk2_hw(silu_f(v1.x), silu_f(v1.y)); o.w = pk2_hw(silu_f(v1.z), silu_f(v1.w));
            if (r >= 130) o = (u32x4){0u, 0u, 0u, 0u};
            *(LAS u32x4*)(scs + r * 264 + 8 * ch) = o; }
    }
    for (int it = blockIdx.x; it < 768; it += F.G) {
        const int layer = it / 384, rem = it % 384, strip = rem >> 3, n0 = strip * 128;
        const float* W = layer ? A.in[I_AWO] : A.in[I_AWE];
        float* PART = (float*)(A.ws + WS_P1) + (size_t)(k8 * 2 + layer) * 130 * 6144;
        { const int c4 = lane & 31, r2 = lane >> 5;
          const float* wp = W + (size_t)(kb + 32 * w + r2) * 6144 + n0 + 4 * c4;
          f32x4 wv[16];
#pragma unroll
          for (int j = 0; j < 16; ++j) wv[j] = __builtin_nontemporal_load((const f32x4*)(wp + (size_t)(2 * j) * 6144));
#pragma unroll
          for (int j = 0; j < 16; ++j) { u32x2 o; o.x = pk2_hw(wv[j].x, wv[j].y); o.y = pk2_hw(wv[j].z, wv[j].w); *(LAS u32x2*)(tile + (32 * w + r2 + 2 * j) * 136 + 4 * c4) = o; } }
        __syncthreads();
        f32x4 acc[9];
#pragma unroll
        for (int m = 0; m < 9; ++m) acc[m] = (f32x4){0.f, 0.f, 0.f, 0.f};
#pragma unroll 2
        for (int ks = 0; ks < 8; ++ks) {
            const bf16x8 b = frag_tr(tile, 136, 16 * w, 32 * ks, lane);
#pragma unroll
            for (int m = 0; m < 9; ++m) acc[m] = MFMA16(frag_nat(scs, 264, 16 * m, 32 * ks, lane), b, acc[m]);
        }
        const int col = n0 + 16 * w + i;
#pragma unroll
        for (int m = 0; m < 9; ++m)
#pragma unroll
            for (int r = 0; r < 4; ++r) { const int row = 16 * m + 4 * g + r; if (row < 130) PART[(size_t)row * 6144 + col] = acc[m][r]; }
        __syncthreads();
    }
}
__device__ __forceinline__ void mods_reduce(const Frame& F, const Args& A) {
    constexpr int PER = 130 * 1536, NV = 2 * PER;
    const f32x4* P = (const f32x4*)(A.ws + WS_P1);
    for (int idx = blockIdx.x * NTHREADS + F.tid; idx < NV; idx += F.G * NTHREADS) {
        const int layer = idx >= PER ? 1 : 0, rem = idx - layer * PER, col4 = rem % 1536;
        f32x4 v[8];
#pragma unroll
        for (int k8 = 0; k8 < 8; ++k8) v[k8] = P[(size_t)(k8 * 2 + layer) * PER + rem];
        f32x4 s = *(const f32x4*)((layer ? A.in[I_ABO] : A.in[I_ABE]) + 4 * col4);
#pragma unroll
        for (int k8 = 0; k8 < 8; ++k8) s += v[k8];
        *(f32x4*)((float*)(A.ws + (layer ? WS_MOD1 : WS_MOD0)) + 4 * (size_t)rem) = s; }
}

__device__ __forceinline__ void norm_row_load(const Args& A, int layer, int row, int lane, f32x4 (&x)[8]) {
    if (layer) { const bf16_t* yr = (const bf16_t*)(A.ws + WS_Y1) + (size_t)row * DM + 4 * lane;
#pragma unroll
        for (int j = 0; j < 8; ++j) { const u32x2 w = *(const u32x2*)(yr + 256 * j); x[j] = (f32x4){bflo(w.x), bfhi(w.x), bflo(w.y), bfhi(w.y)}; } }
    else { const float* xr = (row < TP ? A.in[I_XP] + (size_t)row * DM : A.in[I_XS] + (size_t)(row - TP) * DM) + 4 * lane;
#pragma unroll
        for (int j = 0; j < 8; ++j) x[j] = *(const f32x4*)(xr + 256 * j); }
}
__device__ __forceinline__ void norm_phase(const Frame& F, const Args& A, int layer) {
    const float* MOD = (const float*)(A.ws + (layer ? WS_MOD1 : WS_MOD0));
    const float* gvec = layer ? A.in[I_NGO] : A.in[I_NGE];
    bf16_t* H = (bf16_t*)(A.ws + WS_H);
    const int gw = blockIdx.x * NWAVES + F.wave, NGW = F.G * NWAVES, lane = F.lane;
    f32x4 xn[8];
    if (gw < MROWS) norm_row_load(A, layer, gw, lane, xn);
#pragma unroll 1
    for (int row = gw; row < MROWS; row += NGW) {
        const int b = row < TP ? (row >> 12) : 2 + ((row - TP) >> 2);
        const float* shift = MOD + (size_t)b * 6144; const float* scale = shift + DM;
        f32x4 v[8], gg[8], sc[8], sh[8];
#pragma unroll
        for (int j = 0; j < 8; ++j) { const int c = 4 * lane + 256 * j; v[j] = xn[j]; gg[j] = *(const f32x4*)(gvec + c); sc[j] = *(const f32x4*)(scale + c); sh[j] = *(const f32x4*)(shift + c); }
        if (row + NGW < MROWS) norm_row_load(A, layer, row + NGW, lane, xn);
        __builtin_amdgcn_sched_barrier(0);
        float ss = 0.f;
#pragma unroll
        for (int j = 0; j < 8; ++j) ss += (v[j].x * v[j].x + v[j].y * v[j].y) + (v[j].z * v[j].z + v[j].w * v[j].w);
        const float r = rsqrtf(wave_sum(ss) * (1.f / DM) + EPS);
#pragma unroll
        for (int j = 0; j < 8; ++j) { const int c = 4 * lane + 256 * j;
            const f32x4 h = v[j] * r * gg[j] * (sc[j] + 1.f) + sh[j];
            u32x2 o; o.x = pk2_hw(h.x, h.y); o.y = pk2_hw(h.z, h.w);
            *(u32x2*)(H + (size_t)row * DM + c) = o; }
    }
}

struct EpiP0 {
    static constexpr bool PERM = true;
    bf16_t* P0; float* LR;
    __device__ __forceinline__ void operator()(const f32x4 (&acc)[2][2][4][2], const pg8::Unit& u, int wr, int wc, int fr, int fq) const {
        const int pn = u.pn, row0 = u.pm * 256 + wr * 64 + fr;
        if (pn == 21) {
            if (wc == 0 && fq < 2) {
#pragma unroll
                for (int ai = 0; ai < 2; ++ai)
#pragma unroll
                    for (int m = 0; m < 4; ++m) { float* p = LR + (size_t)(row0 + ai * 128 + m * 16) * 16 + 8 * fq;
                        *(f32x4*)p = acc[ai][0][m][0]; *(f32x4*)(p + 4) = acc[ai][0][m][1]; }
            }
            return;
        }
        const bool do_silu = (pn >= 5 && pn <= 8) || (pn >= 17);
        const float sc = (pn == 9 || pn == 10) ? 0.08838834764831845f : 1.f;
        const int col0 = pn * 256 + wc * 32 + 8 * fq;
#pragma unroll
        for (int ai = 0; ai < 2; ++ai)
#pragma unroll
            for (int m = 0; m < 4; ++m) { bf16_t* rowp = P0 + (size_t)(row0 + ai * 128 + m * 16) * N1 + col0;
#pragma unroll
                for (int bj = 0; bj < 2; ++bj) { f32x4 v0 = acc[ai][bj][m][0] * sc, v1 = acc[ai][bj][m][1] * sc;
                    if (do_silu) {
#pragma unroll
                        for (int j = 0; j < 4; ++j) { v0[j] = silu_f(v0[j]); v1[j] = silu_f(v1[j]); } }
                    u32x4 w; w.x = pg8::cvt_pk_bf16(v0[0], v0[1]); w.y = pg8::cvt_pk_bf16(v0[2], v0[3]); w.z = pg8::cvt_pk_bf16(v1[0], v1[1]); w.w = pg8::cvt_pk_bf16(v1[2], v1[3]);
                    *(u32x4*)(rowp + bj * 128) = w; } }
    }
};
struct EpiY1 {
    static constexpr bool PERM = true;
    const float* base0; const float* mod; bf16_t* out;
    __device__ __forceinline__ void operator()(const f32x4 (&acc)[2][2][4][2], const pg8::Unit& u, int wr, int wc, int fr, int fq) const {
        const int col0 = u.pn * 256 + wc * 32 + 8 * fq;
        const float* gp = mod + (size_t)(u.pm >> 4) * 6144 + 2 * DM + col0;
        f32x4 gt[2][2];
#pragma unroll
        for (int bj = 0; bj < 2; ++bj) { gt[bj][0] = *(const f32x4*)(gp + bj * 128); gt[bj][1] = *(const f32x4*)(gp + bj * 128 + 4); }
#pragma unroll
        for (int ai = 0; ai < 2; ++ai)
#pragma unroll
            for (int mh = 0; mh < 2; ++mh) {
                f32x4 xb[2][2][2];
#pragma unroll
                for (int m2 = 0; m2 < 2; ++m2) { const int row = u.pm * 256 + ai * 128 + wr * 64 + (2 * mh + m2) * 16 + fr; const float* bp = base0 + (size_t)row * DM + col0;
#pragma unroll
                    for (int bj = 0; bj < 2; ++bj) { xb[m2][bj][0] = *(const f32x4*)(bp + bj * 128); xb[m2][bj][1] = *(const f32x4*)(bp + bj * 128 + 4); } }
                __builtin_amdgcn_sched_barrier(0);
#pragma unroll
                for (int m2 = 0; m2 < 2; ++m2) { const int m = 2 * mh + m2, row = u.pm * 256 + ai * 128 + wr * 64 + m * 16 + fr; bf16_t* op = out + (size_t)row * DM + col0;
#pragma unroll
                    for (int bj = 0; bj < 2; ++bj) { const f32x4 v0 = xb[m2][bj][0] + gt[bj][0] * acc[ai][bj][m][0], v1 = xb[m2][bj][1] + gt[bj][1] * acc[ai][bj][m][1];
                        u32x4 w; w.x = pg8::cvt_pk_bf16(v0[0], v0[1]); w.y = pg8::cvt_pk_bf16(v0[2], v0[3]); w.z = pg8::cvt_pk_bf16(v1[0], v1[1]); w.w = pg8::cvt_pk_bf16(v1[2], v1[3]);
                        *(u32x4*)(op + bj * 128) = w; } }
                __builtin_amdgcn_sched_barrier(0); }
    }
};
struct EpiOut {
    static constexpr bool PERM = false;
    const bf16_t* base; const float* mod; float* out;
    __device__ __forceinline__ void operator()(const f32x4 (&acc)[2][2][4][2], const pg8::Unit& u, int wr, int wc, int fr, int fq) const {
        const int col0 = u.pn * 256 + wc * 32 + 4 * fq;
        const float* gp = mod + (size_t)(u.pm >> 4) * 6144 + 2 * DM + col0;
        f32x4 gt[2][2];
#pragma unroll
        for (int bj = 0; bj < 2; ++bj)
#pragma unroll
            for (int n = 0; n < 2; ++n) gt[bj][n] = *(const f32x4*)(gp + bj * 128 + n * 16);
#pragma unroll
        for (int ai = 0; ai < 2; ++ai) {
            u32x2 bw[4][2][2];
#pragma unroll
            for (int m = 0; m < 4; ++m) { const int row = u.pm * 256 + ai * 128 + wr * 64 + m * 16 + fr; const bf16_t* bp = base + (size_t)row * DM + col0;
#pragma unroll
                for (int bj = 0; bj < 2; ++bj)
#pragma unroll
                    for (int n = 0; n < 2; ++n) bw[m][bj][n] = *(const u32x2*)(bp + bj * 128 + n * 16); }
            __builtin_amdgcn_sched_barrier(0);
#pragma unroll
            for (int m = 0; m < 4; ++m) { const int row = u.pm * 256 + ai * 128 + wr * 64 + m * 16 + fr; float* op = out + (size_t)row * DM + col0;
#pragma unroll
                for (int bj = 0; bj < 2; ++bj)
#pragma unroll
                    for (int n = 0; n < 2; ++n) { const u32x2 w2 = bw[m][bj][n]; const f32x4 bs = (f32x4){bflo(w2.x), bfhi(w2.x), bflo(w2.y), bfhi(w2.y)};
                        *(f32x4*)(op + bj * 128 + n * 16) = bs + gt[bj][n] * acc[ai][bj][m][n]; } }
            __builtin_amdgcn_sched_barrier(0); }
    }
};
struct EpiP1 {
    static constexpr bool PERM = true;
    bf16_t* P1; const f32x2* ROT;
    __device__ __forceinline__ void operator()(const f32x4 (&acc)[2][2][4][2], const pg8::Unit& u, int wr, int wc, int fr, int fq) const {
        const int pn = u.pn, row0 = u.pm * 256 + wr * 64 + fr;
        const int col0 = pn * 256 + wc * 32 + 8 * fq;
        if (pn < 16) {
            const float ksc = pn >= 8 ? 0.0625f : 1.f;
            const int d0 = wc * 32 + 8 * fq;
#pragma unroll
            for (int ai = 0; ai < 2; ++ai)
#pragma unroll
                for (int m = 0; m < 4; ++m) { const int row = row0 + ai * 128 + m * 16;
                    const int pi = row < TP ? (row & 4095) : 4096 + (row & 3);
                    const f32x4* rp = (const f32x4*)(ROT + (size_t)pi * 128 + d0);
                    f32x4 o1[2], o2[2];
#pragma unroll
                    for (int n = 0; n < 2; ++n) { const f32x4 cs0 = rp[2 * n], cs1 = rp[2 * n + 1];
                        const f32x4 x1 = acc[ai][0][m][n], x2 = acc[ai][1][m][n];
                        const f32x4 c = (f32x4){cs0.x, cs0.z, cs1.x, cs1.z}, s = (f32x4){cs0.y, cs0.w, cs1.y, cs1.w};
                        o1[n] = (x1 * c - x2 * s) * ksc; o2[n] = (x2 * c + x1 * s) * ksc; }
                    bf16_t* rowp = P1 + (size_t)row * N3 + col0;
                    u32x4 w; w.x = pg8::cvt_pk_bf16(o1[0][0], o1[0][1]); w.y = pg8::cvt_pk_bf16(o1[0][2], o1[0][3]); w.z = pg8::cvt_pk_bf16(o1[1][0], o1[1][1]); w.w = pg8::cvt_pk_bf16(o1[1][2], o1[1][3]);
                    *(u32x4*)rowp = w;
                    w.x = pg8::cvt_pk_bf16(o2[0][0], o2[0][1]); w.y = pg8::cvt_pk_bf16(o2[0][2], o2[0][3]); w.z = pg8::cvt_pk_bf16(o2[1][0], o2[1][1]); w.w = pg8::cvt_pk_bf16(o2[1][2], o2[1][3]);
                    *(u32x4*)(rowp + 128) = w; }
            return;
        }
        const bool do_silu = pn >= 32;
#pragma unroll
        for (int ai = 0; ai < 2; ++ai)
#pragma unroll
            for (int m = 0; m < 4; ++m) { bf16_t* rowp = P1 + (size_t)(row0 + ai * 128 + m * 16) * N3 + col0;
#pragma unroll
                for (int bj = 0; bj < 2; ++bj) { f32x4 v0 = acc[ai][bj][m][0], v1 = acc[ai][bj][m][1];
                    if (do_silu) {
#pragma unroll
                        for (int j = 0; j < 4; ++j) { v0[j] = silu_f(v0[j]); v1[j] = silu_f(v1[j]); } }
                    u32x4 w; w.x = pg8::cvt_pk_bf16(v0[0], v0[1]); w.y = pg8::cvt_pk_bf16(v0[2], v0[3]); w.z = pg8::cvt_pk_bf16(v1[0], v1[1]); w.w = pg8::cvt_pk_bf16(v1[2], v1[3]);
                    *(u32x4*)(rowp + bj * 128) = w; } }
    }
};

template <bool OUT_BF16  >
__device__ __forceinline__ void mini_gemm_sample(const Frame& F, const bf16_t* A  , const bf16_t* Bt  , int K, const void* base1v, const float* mod, void* outv) {
    const int lane = F.lane, w = F.wave, g = lane >> 4, i15 = lane & 15, tid = F.tid;
    LAS float* part = (LAS float*)F.lds;
    for (int tile = blockIdx.x; tile < 256; tile += F.G) {
        const int r0 = (tile >> 5) * 64, c0 = (tile & 31) * 64;
        f32x4 acc[4][4];
#pragma unroll
        for (int m = 0; m < 4; ++m)
#pragma unroll
            for (int n = 0; n < 4; ++n) acc[m][n] = (f32x4){0.f, 0.f, 0.f, 0.f};
        const int kw = K >> 3, nks = kw >> 5;
        const bf16_t* ap = A + (size_t)(r0 + i15) * K + w * kw + 8 * g;
        const bf16_t* bp = Bt + (size_t)(c0 + i15) * K + w * kw + 8 * g;
#pragma unroll 1
        for (int ks = 0; ks < nks; ks += 4) {
            bf16x8 a[4][4], b[4][4];
#pragma unroll
            for (int u = 0; u < 4; ++u)
#pragma unroll
                for (int m = 0; m < 4; ++m) { a[u][m] = *(const bf16x8*)(ap + (size_t)(16 * m) * K + 32 * (ks + u)); b[u][m] = *(const bf16x8*)(bp + (size_t)(16 * m) * K + 32 * (ks + u)); }
            __builtin_amdgcn_sched_barrier(0);
#pragma unroll
            for (int u = 0; u < 4; ++u)
#pragma unroll
                for (int m = 0; m < 4; ++m)
#pragma unroll
                    for (int n = 0; n < 4; ++n) acc[m][n] = MFMA16(a[u][m], b[u][n], acc[m][n]);
            __builtin_amdgcn_sched_barrier(0);
        }
#pragma unroll
        for (int m = 0; m < 4; ++m)
#pragma unroll
            for (int n = 0; n < 4; ++n)
#pragma unroll
                for (int r = 0; r < 4; ++r) part[w * 4096 + (16 * m + 4 * g + r) * 64 + 16 * n + i15] = acc[m][n][r];
        __syncthreads();
        { const int row = tid >> 3, c8 = (tid & 7) * 8;
          f32x4 s0 = (f32x4){0.f, 0.f, 0.f, 0.f}, s1 = s0;
#pragma unroll
          for (int ww = 0; ww < 8; ++ww) { s0 += *(const LAS f32x4*)(part + ww * 4096 + row * 64 + c8); s1 += *(const LAS f32x4*)(part + ww * 4096 + row * 64 + c8 + 4); }
          const int rs = r0 + row, col = c0 + c8;
          const float* gp = mod + (size_t)(2 + (rs >> 2)) * 6144 + 2 * DM + col;
          if constexpr (OUT_BF16) { const float* bs = (const float*)base1v + (size_t)rs * DM + col; bf16_t* op = (bf16_t*)outv + (size_t)(TP + rs) * DM + col;
              const f32x4 v0 = *(const f32x4*)bs + *(const f32x4*)gp * s0, v1 = *(const f32x4*)(bs + 4) + *(const f32x4*)(gp + 4) * s1;
              u32x4 o; o.x = pk2_hw(v0.x, v0.y); o.y = pk2_hw(v0.z, v0.w); o.z = pk2_hw(v1.x, v1.y); o.w = pk2_hw(v1.z, v1.w); *(u32x4*)op = o; }
          else { const bf16_t* bs = (const bf16_t*)base1v + (size_t)rs * DM + col; float* op = (float*)outv + (size_t)(TP + rs) * DM + col;
              const u32x4 bw = *(const u32x4*)bs;
              *(f32x4*)op = (f32x4){bflo(bw.x), bfhi(bw.x), bflo(bw.y), bfhi(bw.y)} + *(const f32x4*)gp * s0;
              *(f32x4*)(op + 4) = (f32x4){bflo(bw.z), bfhi(bw.z), bflo(bw.w), bfhi(bw.w)} + *(const f32x4*)(gp + 4) * s1; } }
        __syncthreads();
    }
}

__device__ __forceinline__ int t5_bucket(int dist) {
    if (dist < 16) return dist;
    const float lr = __logf((float)dist * (1.f / 16.f)) * (1.f / 2.0794415416798357f);
    int large = 16 + (int)(lr * 16.f);
    return large < 31 ? large : 31;
}

__device__ __forceinline__ void swa_prompt_item(const Frame& F, const Args& A, int it) {
    const int b = it >> 6, blk = (it >> 1) & 31, kvh = it & 1;
    int tid = F.tid; asm volatile("" : "+v"(tid));
    const int lane = tid & 63, w = F.wave, g = lane >> 4, i15 = lane & 15, h = kvh * 8 + w;
    const bf16_t* P0 = (const bf16_t*)(A.ws + WS_P0);
    bf16_t* MIX = (bf16_t*)(A.ws + WS_MIX);
    LAS bf16_t* Ks = (LAS bf16_t*)F.lds;
    LAS bf16_t* Vs = Ks + 256 * 72;
    LAS bf16_t* Ps = Vs + 272 * 72;
    LAS float* bias = (LAS float*)(Ps + 8 * 16 * 168);
    const int row0 = b * SEQ + blk * 128;
    const float* qn_g = A.in[I_QNG]; const float* kn_g = A.in[I_KNG];
    { const int ch = tid & 7, rr0 = tid >> 3; const bool has_prev = blk > 0;
      u32x4 kv[4], vv4[4];
#pragma unroll
      for (int i = 0; i < 4; ++i) { const int s = rr0 + 64 * i;
          if (s >= 128 || has_prev) { const size_t grow = (size_t)(row0 - 128 + s) * N1;
              kv[i] = *(const u32x4*)(P0 + grow + C_KA + kvh * 64 + 8 * ch); vv4[i] = *(const u32x4*)(P0 + grow + C_VA + kvh * 64 + 8 * ch); }
          else { kv[i] = (u32x4){0u, 0u, 0u, 0u}; vv4[i] = kv[i]; } }
      float gk[8];
#pragma unroll
      for (int j = 0; j < 8; ++j) gk[j] = kn_g[8 * ch + j];
#pragma unroll
      for (int i = 0; i < 4; ++i) { const int s = rr0 + 64 * i; const unsigned ww[4] = {kv[i].x, kv[i].y, kv[i].z, kv[i].w}; float x[8]; float ss = 0.f;
#pragma unroll
          for (int j = 0; j < 4; ++j) { x[2 * j] = bflo(ww[j]); x[2 * j + 1] = bfhi(ww[j]); ss += x[2 * j] * x[2 * j] + x[2 * j + 1] * x[2 * j + 1]; }
          ss += __shfl_xor(ss, 1); ss += __shfl_xor(ss, 2); ss += __shfl_xor(ss, 4);
          const float r = rsqrtf(ss * (1.f / 64.f) + EPS);
#pragma unroll
          for (int j = 0; j < 8; ++j) x[j] = x[j] * r * gk[j];
          u32x4 o; o.x = pk2(x[0], x[1]); o.y = pk2(x[2], x[3]); o.z = pk2(x[4], x[5]); o.w = pk2(x[6], x[7]);
          *(LAS u32x4*)(Ks + s * 72 + 8 * ch) = o; *(LAS u32x4*)(Vs + s * 72 + 8 * ch) = vv4[i];
          if (blk == 31 && s >= 128) {
              float* kp = A.out + O_KP + ((size_t)(b * 128 + s - 128) * 2 + kvh) * 64 + 8 * ch;
              float* vp = A.out + O_VP + ((size_t)(b * 128 + s - 128) * 2 + kvh) * 64 + 8 * ch;
              *(f32x4*)kp = (f32x4){x[0], x[1], x[2], x[3]}; *(f32x4*)(kp + 4) = (f32x4){x[4], x[5], x[6], x[7]};
              *(f32x4*)vp = (f32x4){bflo(vv4[i].x), bfhi(vv4[i].x), bflo(vv4[i].y), bfhi(vv4[i].y)}; *(f32x4*)(vp + 4) = (f32x4){bflo(vv4[i].z), bfhi(vv4[i].z), bflo(vv4[i].w), bfhi(vv4[i].w)}; } }
      if (tid < 64) { *(LAS u32x4*)(Vs + (256 + (tid >> 2)) * 72 + 16 * (tid & 3)) = (u32x4){0u, 0u, 0u, 0u}; *(LAS u32x4*)(Vs + (256 + (tid >> 2)) * 72 + 16 * (tid & 3) + 8) = (u32x4){0u, 0u, 0u, 0u}; }
      for (int idx = tid; idx < 8 * 129; idx += NTHREADS) { const int hh = idx / 129, d = idx % 129; bias[hh * 132 + d] = A.in[I_RB][t5_bucket(d) * 16 + kvh * 8 + hh]; } }
    const float L2E = 1.4426950408889634f;
    const bf16_t* qp = P0 + (size_t)(row0 + i15) * N1 + C_QA + h * 64 + 8 * g;
    u32x4 qn0 = *(const u32x4*)qp, qn1 = *(const u32x4*)(qp + 32);
    float gq[2][8];
#pragma unroll
    for (int k2 = 0; k2 < 2; ++k2)
#pragma unroll
        for (int j = 0; j < 8; ++j) gq[k2][j] = qn_g[32 * k2 + 8 * g + j] * (0.125f * L2E);
    const float sink2 = A.in[I_SNK][h] * L2E;
    __syncthreads();
    const LAS float* bh_ = bias + w * 132;
    LAS bf16_t* Pw = Ps + w * 16 * 168;
    float bt[9][4];
#pragma unroll
    for (int j = 0; j < 9; ++j)
#pragma unroll
        for (int r = 0; r < 4; ++r) { const int dist = 128 - 16 * j + 4 * g + r - i15; const bool ok = dist >= 0 && dist <= 128; bt[j][r] = ok ? bh_[ok ? dist : 0] * L2E : -1e30f; }
#pragma unroll
    for (int r = 0; r < 4; ++r) Pw[(4 * g + r) * 168 + 144 + i15] = 0;
#pragma unroll 1
    for (int m = 0; m < 8; ++m) {
        u32x4 gv[2];
#pragma unroll
        for (int i = 0; i < 2; ++i) { const int idx = lane + 64 * i; gv[i] = *(const u32x4*)(P0 + (size_t)(row0 + 16 * m + (idx >> 3)) * N1 + C_GA + h * 64 + 8 * (idx & 7)); }
        const u32x4 qc0 = qn0, qc1 = qn1;
        { const int mn = m < 7 ? m + 1 : 7; qn0 = *(const u32x4*)(qp + (size_t)(16 * mn) * N1); qn1 = *(const u32x4*)(qp + (size_t)(16 * mn) * N1 + 32); }
        bf16x8 qf[2];
        { float x[2][8]; float ss = 0.f;
#pragma unroll
          for (int k2 = 0; k2 < 2; ++k2) { const u32x4 qq = k2 ? qc1 : qc0; const unsigned ww[4] = {qq.x, qq.y, qq.z, qq.w};
#pragma unroll
              for (int j = 0; j < 4; ++j) { x[k2][2 * j] = bflo(ww[j]); x[k2][2 * j + 1] = bfhi(ww[j]); ss += x[k2][2 * j] * x[k2][2 * j] + x[k2][2 * j + 1] * x[k2][2 * j + 1]; } }
          ss += __shfl_xor(ss, 16); ss += __shfl_xor(ss, 32);
          const float rq = rsqrtf(ss * (1.f / 64.f) + EPS);
#pragma unroll
          for (int k2 = 0; k2 < 2; ++k2) { u32x4 o; o.x = pk2_hw(x[k2][0] * rq * gq[k2][0], x[k2][1] * rq * gq[k2][1]); o.y = pk2_hw(x[k2][2] * rq * gq[k2][2], x[k2][3] * rq * gq[k2][3]);
              o.z = pk2_hw(x[k2][4] * rq * gq[k2][4], x[k2][5] * rq * gq[k2][5]); o.w = pk2_hw(x[k2][6] * rq * gq[k2][6], x[k2][7] * rq * gq[k2][7]); qf[k2] = __builtin_bit_cast(bf16x8, o); } }
        f32x4 sacc[9];
#pragma unroll
        for (int j = 0; j < 9; ++j) sacc[j] = (f32x4){0.f, 0.f, 0.f, 0.f};
#pragma unroll
        for (int ks = 0; ks < 2; ++ks)
#pragma unroll
            for (int j = 0; j < 9; ++j) sacc[j] = MFMA16(qf[ks], frag_nat(Ks, 72, 16 * (m + j), 32 * ks, lane), sacc[j]);
#pragma unroll
        for (int r = 0; r < 4; ++r) {
            float mx = -1e30f;
#pragma unroll
            for (int j = 0; j < 9; ++j) { const float v = (blk > 0 || m + j >= 8) ? sacc[j][r] + bt[j][r] : -1e30f;
                sacc[j][r] = v; mx = fmaxf(mx, v); }
            mx = fmaxf(red16_max(mx), sink2);
            float sum = 0.f;
#pragma unroll
            for (int j = 0; j < 9; ++j) { const float p = __builtin_amdgcn_exp2f(sacc[j][r] - mx); sacc[j][r] = p; sum += p; }
            sum = red16_sum(sum) + __builtin_amdgcn_exp2f(sink2 - mx);
            const float inv = __builtin_amdgcn_rcpf(sum);
            LAS bf16_t* pr = Pw + (4 * g + r) * 168 + i15;
#pragma unroll
            for (int j = 0; j < 8; j += 2) { const unsigned pk = pk2_hw(sacc[j][r] * inv, sacc[j + 1][r] * inv); pr[16 * j] = (bf16_t)pk; pr[16 * j + 16] = (bf16_t)(pk >> 16); }
            pr[128] = (bf16_t)f2bf_hw(sacc[8][r] * inv);
        }
        f32x4 oacc[4];
#pragma unroll
        for (int e = 0; e < 4; ++e) oacc[e] = (f32x4){0.f, 0.f, 0.f, 0.f};
#pragma unroll
        for (int ks = 0; ks < 5; ++ks) { const bf16x8 a = frag_nat(Pw, 168, 0, 32 * ks, lane);
#pragma unroll
            for (int e = 0; e < 4; ++e) oacc[e] = MFMA16(a, frag_tr(Vs, 72, 16 * e, 16 * m + 32 * ks, lane), oacc[e]); }
#pragma unroll
        for (int r = 0; r < 4; ++r) { LAS bf16_t* pr = Pw + (4 * g + r) * 168 + i15;
#pragma unroll
            for (int e = 0; e < 4; e += 2) { const unsigned pk = pk2_hw(oacc[e][r], oacc[e + 1][r]); pr[16 * e] = (bf16_t)pk; pr[16 * e + 16] = (bf16_t)(pk >> 16); } }
#pragma unroll
        for (int i = 0; i < 2; ++i) { const int idx = lane + 64 * i, tr_ = idx >> 3, c8 = idx & 7; const size_t t = (size_t)(row0 + 16 * m + tr_);
            const u32x4 ov = *(const LAS u32x4*)(Pw + tr_ * 168 + 8 * c8);
            const u32x4 gvv = gv[i];
            u32x4 o;
            o.x = pk2_hw(bflo(ov.x) * bflo(gvv.x), bfhi(ov.x) * bfhi(gvv.x)); o.y = pk2_hw(bflo(ov.y) * bflo(gvv.y), bfhi(ov.y) * bfhi(gvv.y));
            o.z = pk2_hw(bflo(ov.z) * bflo(gvv.z), bfhi(ov.z) * bfhi(gvv.z)); o.w = pk2_hw(bflo(ov.w) * bflo(gvv.w), bfhi(ov.w) * bfhi(gvv.w));
            *(u32x4*)(MIX + t * DM + h * 64 + 8 * c8) = o; }
    }
}

__device__ __forceinline__ void swa_sample_item(const Frame& F, const Args& A, int it) {
    const int bd = it >> 1, kvh = it & 1, tid = F.tid, lane = F.lane, w = F.wave, g = lane >> 4, i15 = lane & 15;
    const bf16_t* P0 = (const bf16_t*)(A.ws + WS_P0);
    bf16_t* MIX = (bf16_t*)(A.ws + WS_MIX);
    LAS bf16_t* Kb = (LAS bf16_t*)F.lds;
    LAS bf16_t* Vb = Kb + 144 * 72;
    LAS bf16_t* Qb = Vb + 160 * 72;
    LAS bf16_t* Pb = Qb + 32 * 72;
    LAS float* Ps = (LAS float*)(Pb + 32 * 168);
    LAS float* bias = Ps + 32 * 148;
    const size_t rowb = (size_t)TP + bd * 4;
    const float* ck = A.in[I_CK]; const float* cv = A.in[I_CV];
    float* oks = A.out + O_KS; float* ovs = A.out + O_VS;
    const int mt = w & 1, ntv = w >> 1;
    f32x4 kq[4], vq[4];
#pragma unroll
    for (int i = 0; i < 4; ++i) { const int idx = tid + NTHREADS * i, j = idx >> 4, d4 = (idx & 15) * 4;
        const size_t gi = ((size_t)(bd * 128 + j) * 2 + kvh) * 64 + d4; kq[i] = *(const f32x4*)(ck + gi); vq[i] = *(const f32x4*)(cv + gi); }
    bf16_t xqr[4], gar[4];
#pragma unroll
    for (int rr = 0; rr < 4; ++rr) { const int r = 4 * w + rr; xqr[rr] = P0[(rowb + (r >> 3)) * N1 + C_QA + (kvh * 8 + (r & 7)) * 64 + lane]; }
    const float gqn = A.in[I_QNG][lane], gkn = A.in[I_KNG][lane];
    const bf16_t xkr = P0[(rowb + (w & 3)) * N1 + C_KA + kvh * 64 + lane], xvr = P0[(rowb + (w & 3)) * N1 + C_VA + kvh * 64 + lane];
    float sk[4];
#pragma unroll
    for (int rr = 0; rr < 4; ++rr) sk[rr] = A.in[I_SNK][kvh * 8 + ((4 * w + rr) & 7)];
#pragma unroll
    for (int q = 0; q < 4; ++q) { const int r = 16 * mt + 4 * g + q; gar[q] = P0[(rowb + (r >> 3)) * N1 + C_GA + (kvh * 8 + (r & 7)) * 64 + 16 * ntv + i15]; }
    float bv[3];
#pragma unroll
    for (int i = 0; i < 3; ++i) { const int idx0 = tid + NTHREADS * i, idx = idx0 < 8 * 129 ? idx0 : 0, gq = idx / 129, dist = idx % 129; bv[i] = A.in[I_RB][t5_bucket(dist) * 16 + kvh * 8 + gq]; }
    __builtin_amdgcn_sched_barrier(0);
#pragma unroll
    for (int i = 0; i < 4; ++i) { const int idx = tid + NTHREADS * i, j = idx >> 4, d4 = (idx & 15) * 4;
        u32x2 kb, vb; kb.x = pk2_hw(kq[i].x, kq[i].y); kb.y = pk2_hw(kq[i].z, kq[i].w); vb.x = pk2_hw(vq[i].x, vq[i].y); vb.y = pk2_hw(vq[i].z, vq[i].w);
        *(LAS u32x2*)(Kb + j * 72 + d4) = kb; *(LAS u32x2*)(Vb + j * 72 + d4) = vb;
        if (j >= 4) { const size_t go = ((size_t)(bd * 128 + j - 4) * 2 + kvh) * 64 + d4; *(f32x4*)(oks + go) = kq[i]; *(f32x4*)(ovs + go) = vq[i]; } }
#pragma unroll
    for (int rr = 0; rr < 4; ++rr) { const int r = 4 * w + rr; const float x = bf2f(xqr[rr]); const float ss = wave_sum(x * x);
        Qb[r * 72 + lane] = (bf16_t)f2bf_hw(x * rsqrtf(ss * (1.f / 64.f) + EPS) * gqn * 0.125f); }
    { const float x = bf2f(xkr); const float ss = wave_sum(x * x);
      const float kn = x * rsqrtf(ss * (1.f / 64.f) + EPS) * gkn, vn = bf2f(xvr);
      if (w < 4) { Kb[(128 + w) * 72 + lane] = (bf16_t)f2bf_hw(kn); Vb[(128 + w) * 72 + lane] = (bf16_t)f2bf_hw(vn);
          const size_t go = ((size_t)(bd * 128 + 124 + w) * 2 + kvh) * 64 + lane; oks[go] = kn; ovs[go] = vn; } }
    if (tid < 108) *(LAS u32x4*)(Kb + 132 * 72 + 8 * tid) = (u32x4){0u, 0u, 0u, 0u};
    else if (tid >= 128 && tid < 128 + 252) *(LAS u32x4*)(Vb + 132 * 72 + 8 * (tid - 128)) = (u32x4){0u, 0u, 0u, 0u};
#pragma unroll
    for (int i = 0; i < 3; ++i) { const int idx = tid + NTHREADS * i; if (idx < 8 * 129) bias[(idx / 129) * 132 + idx % 129] = bv[i]; }
    __syncthreads();
    for (int nt = w; nt < 9; nt += 8) {
        const bf16x8 kb0 = frag_nat(Kb, 72, 16 * nt, 0, lane), kb1 = frag_nat(Kb, 72, 16 * nt, 32, lane);
#pragma unroll
        for (int m = 0; m < 2; ++m) { f32x4 acc = (f32x4){0.f, 0.f, 0.f, 0.f};
            acc = MFMA16(frag_nat(Qb, 72, 16 * m, 0, lane), kb0, acc); acc = MFMA16(frag_nat(Qb, 72, 16 * m, 32, lane), kb1, acc);
#pragma unroll
            for (int q = 0; q < 4; ++q) { const int r = 16 * m + 4 * g + q, l = r >> 3, gq = r & 7, s = 16 * nt + i15, dist = 128 + l - s;
                const bool ok = dist >= 0 && dist <= 128;
                Ps[r * 148 + s] = ok ? acc[q] + bias[gq * 132 + (ok ? dist : 0)] : -1e30f; } } }
    __syncthreads();
#pragma unroll
    for (int rr = 0; rr < 4; ++rr) { const int r = 4 * w + rr; const float sink = sk[rr];
        const float v0 = Ps[r * 148 + lane], v1 = Ps[r * 148 + 64 + lane], v2 = lane < 4 ? Ps[r * 148 + 128 + lane] : -1e30f;
        float mx = fmaxf(fmaxf(v0, v1), v2);
#pragma unroll
        for (int o = 1; o < 64; o <<= 1) mx = fmaxf(mx, __shfl_xor(mx, o));
        mx = fmaxf(mx, sink);
        const float p0 = __expf(v0 - mx), p1 = __expf(v1 - mx), p2 = lane < 4 ? __expf(v2 - mx) : 0.f;
        const float inv = 1.f / (wave_sum(p0 + p1 + p2) + __expf(sink - mx));
        Pb[r * 168 + lane] = (bf16_t)f2bf_hw(p0 * inv); Pb[r * 168 + 64 + lane] = (bf16_t)f2bf_hw(p1 * inv); if (lane < 40) Pb[r * 168 + 128 + lane] = (bf16_t)f2bf_hw(p2 * inv); }
    __syncthreads();
    { f32x4 o = (f32x4){0.f, 0.f, 0.f, 0.f};
#pragma unroll
      for (int ks = 0; ks < 5; ++ks) o = MFMA16(frag_nat(Pb, 168, 16 * mt, 32 * ks, lane), frag_tr(Vb, 72, 16 * ntv, 32 * ks, lane), o);
#pragma unroll
      for (int q = 0; q < 4; ++q) { const int r = 16 * mt + 4 * g + q;
          MIX[(rowb + (r >> 3)) * DM + (kvh * 8 + (r & 7)) * 64 + 16 * ntv + i15] = (bf16_t)f2bf_hw(o[q] * bf2f(gar[q])); } }
}

__device__ __forceinline__ void gla_sample_item(const Frame& F, const Args& A, int it) {
    const int bd = it >> 2, h = it & 3, tid = F.tid, lane = F.lane, w = F.wave;
    const bf16_t* P0 = (const bf16_t*)(A.ws + WS_P0);
    const float* LR = (const float*)(A.ws + WS_LR);
    bf16_t* MIX = (bf16_t*)(A.ws + WS_MIX);
    LAS float* qt = (LAS float*)F.lds;
    LAS float* kt = qt + 512;
    LAS float* kd = kt + 512;
    LAS float* dec = kd + 512;
    LAS float* vv = dec + 128;
    LAS float* Am = vv + 1024;
    LAS float* OACC = Am + 16;
    LAS float* red = OACC + 8 * 4 * 256;
    const size_t rowb = (size_t)TP + bd * 4;
    f32x4 s0[16];
    { const float* S0 = A.in[I_SG] + ((size_t)(bd * 4 + h) * 128 + (tid >> 6) * 16) * 256 + 4 * (tid & 63);
#pragma unroll
      for (int j = 0; j < 16; ++j) s0[j] = __builtin_nontemporal_load((const f32x4*)(S0 + (size_t)j * 256)); }
    if (tid < 128) { const int d = tid; float bc[4]; float run = 0.f;
        const float* wl = A.in[I_WLR] + h * 128 + d;
        float wv[16]; f32x4 lrv[16]; float qv[4], kv[4];
#pragma unroll
        for (int j = 0; j < 16; ++j) { wv[j] = wl[j * 512]; lrv[j] = *(const f32x4*)(LR + rowb * 16 + 4 * j); }
#pragma unroll
        for (int t = 0; t < 4; ++t) { qv[t] = bf2f(P0[(rowb + t) * N1 + C_QB + h * 128 + d]); kv[t] = bf2f(P0[(rowb + t) * N1 + C_KB + h * 128 + d]); }
        const float bl = A.in[I_BLR][h * 128 + d];
        __builtin_amdgcn_sched_barrier(0);
#pragma unroll
        for (int t = 0; t < 4; ++t) { float z = bl;
#pragma unroll
            for (int j4 = 0; j4 < 4; ++j4) { const f32x4 l = lrv[4 * t + j4]; z += l.x * wv[4 * j4] + l.y * wv[4 * j4 + 1] + l.z * wv[4 * j4 + 2] + l.w * wv[4 * j4 + 3]; }
            run += logsig_f(z) * (1.f / 16.f); bc[t] = run; }
#pragma unroll
        for (int t = 0; t < 4; ++t) { const float q = qv[t], k = kv[t];
            qt[t * 128 + d] = q * __expf(bc[t]); kt[t * 128 + d] = k * __expf(-bc[t]); kd[t * 128 + d] = k * __expf(bc[3] - bc[t]); }
        dec[d] = __expf(bc[3]); }
    { const int e = tid & 255, t0 = (tid >> 8) * 2;
      vv[t0 * 256 + e] = bf2f(P0[(rowb + t0) * N1 + C_VB + h * 256 + e]); vv[(t0 + 1) * 256 + e] = bf2f(P0[(rowb + t0 + 1) * N1 + C_VB + h * 256 + e]); }
    __syncthreads();
    { const int pair = tid >> 5, sub = tid & 31, t = pair >> 2, s = pair & 3; float p = 0.f;
#pragma unroll
      for (int i = 0; i < 4; ++i) p += qt[t * 128 + sub + 32 * i] * kt[s * 128 + sub + 32 * i];
      p += __shfl_xor(p, 1); p += __shfl_xor(p, 2); p += __shfl_xor(p, 4); p += __shfl_xor(p, 8); p += __shfl_xor(p, 16);
      if (sub == 0) Am[pair] = (s <= t) ? p : 0.f; }
    { const int e4 = tid & 63, dg = tid >> 6;
      const float* S0 = A.in[I_SG] + ((size_t)(bd * 4 + h) * 128 + dg * 16) * 256 + 4 * e4;
      float* SN = A.out + O_GS + ((size_t)(bd * 4 + h) * 128 + dg * 16) * 256 + 4 * e4;
      f32x4 vr[4];
#pragma unroll
      for (int t = 0; t < 4; ++t) vr[t] = *(const LAS f32x4*)(vv + t * 256 + 4 * e4);
      f32x4 oa[4];
#pragma unroll
      for (int t = 0; t < 4; ++t) oa[t] = (f32x4){0.f, 0.f, 0.f, 0.f};
      {
#pragma unroll
        for (int j = 0; j < 16; ++j) { const int d = dg * 16 + j;
            f32x4 sn = s0[j] * dec[d];
#pragma unroll
            for (int t = 0; t < 4; ++t) { sn += vr[t] * kd[t * 128 + d]; oa[t] += s0[j] * qt[t * 128 + d]; }
            __builtin_nontemporal_store(sn, (f32x4*)(SN + (size_t)j * 256)); } }
#pragma unroll
      for (int t = 0; t < 4; ++t) *(LAS f32x4*)(OACC + (dg * 4 + t) * 256 + 4 * e4) = oa[t]; }
    __syncthreads();
    { const int e = tid & 255, t0 = (tid >> 8) * 2; float o[2];
#pragma unroll
      for (int tt = 0; tt < 2; ++tt) { const int t = t0 + tt; float s = 0.f;
#pragma unroll
          for (int dgi = 0; dgi < 8; ++dgi) s += OACC[(dgi * 4 + t) * 256 + e];
#pragma unroll
          for (int s2 = 0; s2 < 4; ++s2) s += Am[t * 4 + s2] * vv[s2 * 256 + e];
          o[tt] = s; }
      const float s0 = wave_sum(o[0] * o[0]), s1 = wave_sum(o[1] * o[1]);
      if (lane == 0) { red[w * 2] = s0; red[w * 2 + 1] = s1; }
      __syncthreads();
      const int wb = (tid >> 8) * 4;
      const float q0 = red[wb * 2] + red[(wb + 1) * 2] + red[(wb + 2) * 2] + red[(wb + 3) * 2];
      const float q1 = red[wb * 2 + 1] + red[(wb + 1) * 2 + 1] + red[(wb + 2) * 2 + 1] + red[(wb + 3) * 2 + 1];
      const float gg = A.in[I_GLG][e];
      const float r0 = rsqrtf(q0 * (1.f / 256.f) + EPS), r1 = rsqrtf(q1 * (1.f / 256.f) + EPS);
      const float g0 = bf2f(P0[(rowb + t0) * N1 + C_GB + h * 256 + e]), g1 = bf2f(P0[(rowb + t0 + 1) * N1 + C_GB + h * 256 + e]);
      MIX[(rowb + t0) * DM + 1024 + h * 256 + e] = (bf16_t)f2bf(o[0] * r0 * gg * g0);
      MIX[(rowb + t0 + 1) * DM + 1024 + h * 256 + e] = (bf16_t)f2bf(o[1] * r1 * gg * g1); }
}

__device__ __forceinline__ void gla_state_item(const Frame& F, const Args& A, int it) {
    const int bh = it >> 3, db = it & 7, b = bh >> 2, h = bh & 3;
    const int tid = F.tid, lane = F.lane, w = F.wave, g = lane >> 4, i15 = lane & 15;
    const bf16_t* P0 = (const bf16_t*)(A.ws + WS_P0);
    const float* LR = (const float*)(A.ws + WS_LR);
    bf16_t* SPG = (bf16_t*)(A.ws + WS_SPG);
    LAS float* WL = (LAS float*)F.lds;
    LAS float* BL = WL + 256;
    LAS float* DEC = BL + 16;
    LAS bf16_t* KD = (LAS bf16_t*)(DEC + 32);
    LAS bf16_t* STW = KD + 2 * 64 * 24;
    LAS bf16_t* VS = STW + 4 * 64 * 16;
    if (tid < 256) WL[tid] = A.in[I_WLR][(tid >> 4) * 512 + h * 128 + db * 16 + (tid & 15)];
    if (tid < 16) BL[tid] = A.in[I_BLR][h * 128 + db * 16 + tid];
    __syncthreads();
    const size_t rowb = (size_t)b * SEQ;
    const bool prep = w < 4;
    const float* lp = LR + (rowb + lane) * 16;
    const bf16_t* kp = P0 + (rowb + lane) * N1 + C_KB + h * 128 + db * 16 + 4 * (w & 3);
    const bf16_t* vp = P0 + (rowb + ((tid & 255) >> 5)) * N1 + C_VB + h * 256 + 8 * (tid & 31);
    f32x4 lrA[4], lrB[4]; u32x2 kA = (u32x2){0u, 0u}, kB = kA; u32x4 vA[8], vB[8];
#define GSP_LOAD(LRR, KK, VV, cc) do { const size_t _o = (size_t)(cc) * 64; \
        _Pragma("unroll") for (int _j = 0; _j < 4; ++_j) LRR[_j] = *(const f32x4*)(lp + _o * 16 + 4 * _j); \
        KK = *(const u32x2*)(kp + _o * N1); \
        _Pragma("unroll") for (int _i = 0; _i < 8; ++_i) VV[_i] = *(const u32x4*)(vp + (_o + 8 * _i) * N1); } while (0)
#define GSP_PREP(LRR, KK, VV, nb) do { \
        f32x4 _zz = blr; \
        _Pragma("unroll") for (int _j = 0; _j < 4; ++_j) { _zz += wlr[4 * _j] * LRR[_j].x; _zz += wlr[4 * _j + 1] * LRR[_j].y; _zz += wlr[4 * _j + 2] * LRR[_j].z; _zz += wlr[4 * _j + 3] * LRR[_j].w; } \
        const float _z[4] = {_zz.x, _zz.y, _zz.z, _zz.w}; \
        float _bc[4], _tot[4]; \
        _Pragma("unroll") for (int _q = 0; _q < 4; ++_q) { const float _v = wave_incl_scan(logsig_f(_z[_q]) * (1.f / 16.f)); \
            _bc[_q] = _v; _tot[_q] = __builtin_bit_cast(float, __builtin_amdgcn_readlane(__builtin_bit_cast(int, _v), 63)); } \
        const float _k0 = bflo(KK.x), _k1 = bfhi(KK.x), _k2 = bflo(KK.y), _k3 = bfhi(KK.y); \
        u32x2 _o2; _o2.x = pg8::cvt_pk_bf16(_k0 * __expf(_tot[0] - _bc[0]), _k1 * __expf(_tot[1] - _bc[1])); _o2.y = pg8::cvt_pk_bf16(_k2 * __expf(_tot[2] - _bc[2]), _k3 * __expf(_tot[3] - _bc[3])); \
        *(LAS u32x2*)(KD + (nb) * (64 * 24) + lane * 24 + 4 * (w & 3)) = _o2; \
        if (lane == 0) { _Pragma("unroll") for (int _q = 0; _q < 4; ++_q) DEC[(nb) * 16 + 4 * (w & 3) + _q] = __expf(_tot[_q]); } \
        _Pragma("unroll") for (int _i = 0; _i < 8; ++_i) *(LAS u32x4*)(VS + (nb) * (64 * 264) + (((tid & 255) >> 5) + 8 * _i) * 264 + 8 * (tid & 31)) = VV[_i]; } while (0)
    f32x4 wlr[16], blr;
#pragma unroll
    for (int j = 0; j < 16; ++j) wlr[j] = *(const LAS f32x4*)(WL + j * 16 + 4 * (w & 3));
    blr = *(const LAS f32x4*)(BL + 4 * (w & 3));
    const int mw = w & 3;
    f32x4 S[4];
#pragma unroll
    for (int n = 0; n < 4; ++n) S[n] = (f32x4){0.f, 0.f, 0.f, 0.f};
    LAS bf16_t* stw = STW + mw * (64 * 16);
#define GSC_STEP(cc) do { const int _cb = (cc) & 1; \
        _Pragma("unroll") for (int _n = 0; _n < 4; ++_n) { const unsigned _p0 = pg8::cvt_pk_bf16(S[_n][0], S[_n][1]), _p1 = pg8::cvt_pk_bf16(S[_n][2], S[_n][3]); \
            stw[(16 * _n + 4 * g + 0) * 16 + i15] = (bf16_t)_p0; stw[(16 * _n + 4 * g + 1) * 16 + i15] = (bf16_t)(_p0 >> 16); \
            stw[(16 * _n + 4 * g + 2) * 16 + i15] = (bf16_t)_p1; stw[(16 * _n + 4 * g + 3) * 16 + i15] = (bf16_t)(_p1 >> 16); } \
        { bf16_t* _dst = SPG + ((size_t)(bh * 64 + (cc)) * 256 + 64 * mw + lane) * 128 + db * 16; \
          *(u32x4*)_dst = *(const LAS u32x4*)(stw + lane * 16); *(u32x4*)(_dst + 8) = *(const LAS u32x4*)(stw + lane * 16 + 8); } \
        f32x4 _nw[4]; \
        _Pragma("unroll") for (int _n = 0; _n < 4; ++_n) _nw[_n] = (f32x4){0.f, 0.f, 0.f, 0.f}; \
        _Pragma("unroll") for (int _ks = 0; _ks < 2; ++_ks) { const bf16x8 _bb = frag_tr(KD + _cb * (64 * 24), 24, 0, 32 * _ks, lane); \
            _Pragma("unroll") for (int _n = 0; _n < 4; ++_n) _nw[_n] = MFMA16(frag_tr(VS + _cb * (64 * 264), 264, 64 * mw + 16 * _n, 32 * _ks, lane), _bb, _nw[_n]); } \
        const float _dc = DEC[_cb * 16 + i15]; \
        _Pragma("unroll") for (int _n = 0; _n < 4; ++_n) S[_n] = S[_n] * _dc + _nw[_n]; } while (0)
    if (prep) { GSP_LOAD(lrA, kA, vA, 0); GSP_LOAD(lrB, kB, vB, 1); GSP_PREP(lrA, kA, vA, 0); GSP_LOAD(lrA, kA, vA, 2); }
    __syncthreads();
#pragma unroll 1
    for (int c = 0; c < 64; c += 2) {
        if (prep) { GSP_PREP(lrB, kB, vB, 1); if (c + 3 < 64) GSP_LOAD(lrB, kB, vB, c + 3); }
        else GSC_STEP(c);
        __syncthreads();
        if (prep) { if (c + 2 < 64) { GSP_PREP(lrA, kA, vA, 0); if (c + 4 < 64) GSP_LOAD(lrA, kA, vA, c + 4); } }
        else GSC_STEP(c + 1);
        __syncthreads();
    }
#undef GSP_LOAD
#undef GSP_PREP
#undef GSC_STEP
    if (!prep) { int ln = lane; asm volatile("" : "+v"(ln));
        float* gp = A.out + O_GP + ((size_t)bh * 128 + db * 16 + (ln & 15)) * 256 + 64 * mw + 4 * (ln >> 4);
#pragma unroll
        for (int n = 0; n < 4; ++n) *(f32x4*)(gp + 16 * n) = S[n]; }
}

__device__ __forceinline__ void gla_out_item(const Frame& F, const Args& A, int it) {
    const int bh = it >> 6, c = it & 63, b = bh >> 2, h = bh & 3;
    const int tid = F.tid, lane = F.lane, w = F.wave, g = lane >> 4, i15 = lane & 15;
    const bf16_t* P0 = (const bf16_t*)(A.ws + WS_P0);
    const float* LR = (const float*)(A.ws + WS_LR);
    const bf16_t* SPG = (const bf16_t*)(A.ws + WS_SPG);
    bf16_t* MIX = (bf16_t*)(A.ws + WS_MIX);
    LAS float* WL = (LAS float*)F.lds;
    LAS float* BL = WL + 2048;
    LAS float* LRs = BL + 128;
    LAS float* LA = LRs + 1024;
    LAS float* SEG = LA + 64 * 129;
    LAS bf16_t* QT = (LAS bf16_t*)(SEG + 512);
    LAS bf16_t* KT = QT + 64 * 136;
    LAS bf16_t* VS = KT + 64 * 136;
    LAS bf16_t* AM = VS + 64 * 264;
    LAS float* RS = (LAS float*)(AM + 64 * 72);
    const size_t row0 = (size_t)b * SEQ + c * 64;
    const int t8 = tid >> 3, c8 = tid & 7;
    const bf16_t* qsrc = P0 + (row0 + t8) * N1 + C_QB + h * 128 + 16 * c8;
    const bf16_t* ksrc = P0 + (row0 + t8) * N1 + C_KB + h * 128 + 16 * c8;
    const u32x4 q0 = *(const u32x4*)qsrc, q1 = *(const u32x4*)(qsrc + 8), k0 = *(const u32x4*)ksrc, k1 = *(const u32x4*)(ksrc + 8);
    { const bf16_t* vsrc = P0 + (row0 + t8) * N1 + C_VB + h * 256 + 32 * c8;
#pragma unroll
      for (int j = 0; j < 4; ++j) *(LAS u32x4*)(VS + t8 * 264 + 32 * c8 + 8 * j) = *(const u32x4*)(vsrc + 8 * j); }
    { float wv[4];
#pragma unroll
      for (int i = 0; i < 4; ++i) { const int idx = tid + NTHREADS * i; wv[i] = A.in[I_WLR][(idx >> 7) * 512 + h * 128 + (idx & 127)]; }
      const float blv = A.in[I_BLR][h * 128 + (tid & 127)];
      const f32x4 lv = *(const f32x4*)(LR + row0 * 16 + 4 * (tid & 255));
#pragma unroll
      for (int i = 0; i < 4; ++i) WL[tid + NTHREADS * i] = wv[i];
      if (tid < 128) BL[tid] = blv;
      if (tid < 256) *(LAS f32x4*)(LRs + 4 * tid) = lv; }
    __syncthreads();
    { float lr[16];
#pragma unroll
      for (int j = 0; j < 16; ++j) lr[j] = LRs[t8 * 16 + j];
#pragma unroll
      for (int q = 0; q < 16; ++q) { const int d = 16 * c8 + q; float z = BL[d];
#pragma unroll
          for (int j = 0; j < 16; ++j) z += lr[j] * WL[j * 128 + d];
          LA[t8 * 129 + d] = logsig_f(z) * (1.f / 16.f); } }
    __syncthreads();
    { const int d = tid & 127, seg = tid >> 7; float p[16]; float run = 0.f;
#pragma unroll
      for (int q = 0; q < 16; ++q) { run += LA[(16 * seg + q) * 129 + d]; p[q] = run; }
      SEG[seg * 128 + d] = run;
      __syncthreads();
      float off = 0.f;
#pragma unroll
      for (int s2 = 0; s2 < 3; ++s2) off += (s2 < seg) ? SEG[s2 * 128 + d] : 0.f;
#pragma unroll
      for (int q = 0; q < 16; ++q) LA[(16 * seg + q) * 129 + d] = off + p[q]; }
    __syncthreads();
    { const unsigned qw[8] = {q0.x, q0.y, q0.z, q0.w, q1.x, q1.y, q1.z, q1.w}, kw[8] = {k0.x, k0.y, k0.z, k0.w, k1.x, k1.y, k1.z, k1.w};
      unsigned qo[8], ko[8];
#pragma unroll
      for (int j = 0; j < 8; ++j) { const float b0 = LA[t8 * 129 + 16 * c8 + 2 * j], b1 = LA[t8 * 129 + 16 * c8 + 2 * j + 1];
          qo[j] = pk2_hw(bflo(qw[j]) * __expf(b0), bfhi(qw[j]) * __expf(b1)); ko[j] = pk2_hw(bflo(kw[j]) * __expf(-b0), bfhi(kw[j]) * __expf(-b1)); }
      *(LAS u32x4*)(QT + t8 * 136 + 16 * c8) = (u32x4){qo[0], qo[1], qo[2], qo[3]}; *(LAS u32x4*)(QT + t8 * 136 + 16 * c8 + 8) = (u32x4){qo[4], qo[5], qo[6], qo[7]};
      *(LAS u32x4*)(KT + t8 * 136 + 16 * c8) = (u32x4){ko[0], ko[1], ko[2], ko[3]}; *(LAS u32x4*)(KT + t8 * 136 + 16 * c8 + 8) = (u32x4){ko[4], ko[5], ko[6], ko[7]}; }
    __syncthreads();
    { const int tt = w >> 1, st0 = 2 * (w & 1);
      f32x4 a0 = (f32x4){0.f, 0.f, 0.f, 0.f}, a1 = a0;
#pragma unroll
      for (int ks = 0; ks < 4; ++ks) { const bf16x8 a = frag_nat(QT, 136, 16 * tt, 32 * ks, lane);
          a0 = MFMA16(a, frag_nat(KT, 136, 16 * st0, 32 * ks, lane), a0); a1 = MFMA16(a, frag_nat(KT, 136, 16 * st0 + 16, 32 * ks, lane), a1); }
#pragma unroll
      for (int r = 0; r < 4; ++r) { const int t = 16 * tt + 4 * g + r, s0 = 16 * st0 + i15, s1 = s0 + 16;
          AM[t * 72 + s0] = (bf16_t)f2bf_hw(s0 <= t ? a0[r] : 0.f); AM[t * 72 + s1] = (bf16_t)f2bf_hw(s1 <= t ? a1[r] : 0.f); } }
    __syncthreads();
    f32x4 acc[4][2];
#pragma unroll
    for (int m = 0; m < 4; ++m) { acc[m][0] = (f32x4){0.f, 0.f, 0.f, 0.f}; acc[m][1] = acc[m][0]; }
#pragma unroll
    for (int ks = 0; ks < 2; ++ks) { const bf16x8 b0 = frag_tr(VS, 264, 32 * w, 32 * ks, lane), b1 = frag_tr(VS, 264, 32 * w + 16, 32 * ks, lane);
#pragma unroll
        for (int m = 0; m < 4; ++m) { const bf16x8 a = frag_nat(AM, 72, 16 * m, 32 * ks, lane); acc[m][0] = MFMA16(a, b0, acc[m][0]); acc[m][1] = MFMA16(a, b1, acc[m][1]); } }
    { const bf16_t* sp = SPG + ((size_t)(bh * 64 + c) * 256 + 32 * w + i15) * 128 + 8 * g;
      bf16x8 sb[4][2];
#pragma unroll
      for (int ks = 0; ks < 4; ++ks) { sb[ks][0] = *(const bf16x8*)(sp + 32 * ks); sb[ks][1] = *(const bf16x8*)(sp + 16 * 128 + 32 * ks); }
      __builtin_amdgcn_sched_barrier(0);
#pragma unroll
      for (int ks = 0; ks < 4; ++ks) {
#pragma unroll
          for (int m = 0; m < 4; ++m) { const bf16x8 a = frag_nat(QT, 136, 16 * m, 32 * ks, lane); acc[m][0] = MFMA16(a, sb[ks][0], acc[m][0]); acc[m][1] = MFMA16(a, sb[ks][1], acc[m][1]); } } }
#pragma unroll
    for (int m = 0; m < 4; ++m)
#pragma unroll
        for (int r = 0; r < 4; ++r) { float ss = acc[m][0][r] * acc[m][0][r] + acc[m][1][r] * acc[m][1][r]; ss = red16_sum(ss); if (i15 == 0) RS[w * 64 + 16 * m + 4 * g + r] = ss; }
    __syncthreads();
    { const float g0 = A.in[I_GLG][32 * w + i15], g1 = A.in[I_GLG][32 * w + 16 + i15];
#pragma unroll
      for (int m = 0; m < 4; ++m)
#pragma unroll
          for (int r = 0; r < 4; ++r) { const int t = 16 * m + 4 * g + r; float q = 0.f;
#pragma unroll
              for (int ww = 0; ww < 8; ++ww) q += RS[ww * 64 + t];
              const float rr = rsqrtf(q * (1.f / 256.f) + EPS);
              VS[t * 264 + 32 * w + i15] = (bf16_t)f2bf_hw(acc[m][0][r] * rr * g0);
              VS[t * 264 + 32 * w + 16 + i15] = (bf16_t)f2bf_hw(acc[m][1][r] * rr * g1); } }
    u32x4 gva[4];
#pragma unroll
    for (int i = 0; i < 4; ++i) { const int idx = tid + NTHREADS * i, t = idx >> 5, ch = idx & 31; gva[i] = *(const u32x4*)(P0 + (row0 + t) * N1 + C_GB + h * 256 + 8 * ch); }
    __syncthreads();
#pragma unroll
    for (int i = 0; i < 4; ++i) { const int idx = tid + NTHREADS * i, t = idx >> 5, ch = idx & 31;
        const u32x4 ov = *(const LAS u32x4*)(VS + t * 264 + 8 * ch);
        const u32x4 gv = gva[i];
        u32x4 o;
        o.x = pk2_hw(bflo(ov.x) * bflo(gv.x), bfhi(ov.x) * bfhi(gv.x)); o.y = pk2_hw(bflo(ov.y) * bflo(gv.y), bfhi(ov.y) * bfhi(gv.y));
        o.z = pk2_hw(bflo(ov.z) * bflo(gv.z), bfhi(ov.z) * bfhi(gv.z)); o.w = pk2_hw(bflo(ov.w) * bflo(gv.w), bfhi(ov.w) * bfhi(gv.w));
        *(u32x4*)(MIX + (row0 + t) * DM + 1024 + h * 256 + 8 * ch) = o; }
}

__device__ __forceinline__ float ret_log2_gamma(int h) { return log1pf(-exp2f(-5.f - (float)h)) * 1.4426950408889634f; }

__device__ __forceinline__ void ret_sample_item(const Frame& F, const Args& A, int it) {
    const int bd = it >> 3, h = it & 7, tid = F.tid, lane = F.lane, w = F.wave;
    const bf16_t* P1 = (const bf16_t*)(A.ws + WS_P1);
    bf16_t* RO = (bf16_t*)(A.ws + WS_RO);
    LAS float* q = (LAS float*)F.lds;
    LAS float* k = q + 1024;
    LAS float* vv = k + 1024;
    LAS float* Am = vv + 2048;
    LAS float* red = Am + 16;
    LAS float* OACC = red + 16;
    const size_t rowb = (size_t)TP + bd * 4;
    const float l2g = ret_log2_gamma(h);
    { const int d = tid & 255, t0 = (tid >> 8) * 2;
#pragma unroll
      for (int tt = 0; tt < 2; ++tt) { const int t = t0 + tt; q[t * 256 + d] = bf2f(P1[(rowb + t) * N3 + C_Q + h * 256 + d]); k[t * 256 + d] = bf2f(P1[(rowb + t) * N3 + C_K + h * 256 + d]); } }
#pragma unroll
    for (int t = 0; t < 4; ++t) vv[t * 512 + tid] = bf2f(P1[(rowb + t) * N3 + C_V + h * 512 + tid]);
    __syncthreads();
    { const int pair = tid >> 5, sub = tid & 31, t = pair >> 2, s = pair & 3; float p = 0.f;
#pragma unroll
      for (int i = 0; i < 8; ++i) p += q[t * 256 + sub + 32 * i] * k[s * 256 + sub + 32 * i];
      p += __shfl_xor(p, 1); p += __shfl_xor(p, 2); p += __shfl_xor(p, 4); p += __shfl_xor(p, 8); p += __shfl_xor(p, 16);
      if (sub == 0) Am[pair] = (s <= t) ? p * exp2f(l2g * (float)(t - s)) : 0.f; }
    { const int e4 = tid & 127, dg = tid >> 7;
      const float* S0 = A.in[I_SR] + ((size_t)(bd * 8 + h) * 256 + dg * 64) * 512 + 4 * e4;
      float* SN = A.out + O_RS + ((size_t)(bd * 8 + h) * 256 + dg * 64) * 512 + 4 * e4;
      f32x4 vr[4];
      const float kdsc[4] = {exp2f(l2g * 3.f), exp2f(l2g * 2.f), exp2f(l2g), 1.f};
#pragma unroll
      for (int t = 0; t < 4; ++t) vr[t] = *(const LAS f32x4*)(vv + t * 512 + 4 * e4) * kdsc[t];
      const float g4 = exp2f(l2g * 4.f);
      f32x4 oa[4];
#pragma unroll
      for (int t = 0; t < 4; ++t) oa[t] = (f32x4){0.f, 0.f, 0.f, 0.f};
#pragma unroll 1
      for (int i0 = 0; i0 < 64; i0 += 32) {
          f32x4 s0[32];
#pragma unroll
          for (int j = 0; j < 32; ++j) s0[j] = __builtin_nontemporal_load((const f32x4*)(S0 + (size_t)(i0 + j) * 512));
#pragma unroll
          for (int j = 0; j < 32; ++j) { const int d = dg * 64 + i0 + j;
              f32x4 sn = s0[j] * g4;
#pragma unroll
              for (int t = 0; t < 4; ++t) { sn += vr[t] * k[t * 256 + d]; oa[t] += s0[j] * q[t * 256 + d]; }
              __builtin_nontemporal_store(sn, (f32x4*)(SN + (size_t)(i0 + j) * 512)); } }
#pragma unroll
      for (int t = 0; t < 4; ++t) *(LAS f32x4*)(OACC + (dg * 4 + t) * 512 + 4 * e4) = oa[t]; }
    __syncthreads();
    { const int e = tid; float o[4];
#pragma unroll
      for (int t = 0; t < 4; ++t) { float s = 0.f;
#pragma unroll
          for (int dgi = 0; dgi < 4; ++dgi) s += OACC[(dgi * 4 + t) * 512 + e];
          s *= exp2f(l2g * (float)(t + 1));
#pragma unroll
          for (int s2 = 0; s2 < 4; ++s2) s += Am[t * 4 + s2] * vv[s2 * 512 + e];
          o[t] = s; }
      const float gg = A.in[I_RTG][e];
      bf16_t gsr[4];
#pragma unroll
      for (int t = 0; t < 4; ++t) gsr[t] = P1[(rowb + t) * N3 + C_G + h * 512 + e];
      float ssq[4];
#pragma unroll
      for (int t = 0; t < 4; ++t) ssq[t] = wave_sum(o[t] * o[t]);
      __syncthreads();
      if (lane == 0) {
#pragma unroll
          for (int t = 0; t < 4; ++t) OACC[w * 4 + t] = ssq[t]; }
      __syncthreads();
#pragma unroll
      for (int t = 0; t < 4; ++t) { float qsum = 0.f;
#pragma unroll
          for (int ww = 0; ww < 8; ++ww) qsum += OACC[ww * 4 + t];
          const float rr = rsqrtf(qsum * (1.f / 512.f) + EPS);
          const float gs = bf2f(gsr[t]);
          RO[(rowb + t) * KO1 + h * 512 + e] = (bf16_t)f2bf_hw(o[t] * rr * gg * gs); } }
}

__device__ __forceinline__ void ret_state_item(const Frame& F, const Args& A, int it) {
    const int bh = it >> 3, eb = (it >> 1) & 3, db = it & 1, b = bh >> 3, h = bh & 7;
    const int tid = F.tid, lane = F.lane, w = F.wave, g = lane >> 4, i15 = lane & 15;
    const bf16_t* P1 = (const bf16_t*)(A.ws + WS_P1);
    bf16_t* SPR = (bf16_t*)(A.ws + WS_SPR);
    LAS bf16_t* KD = (LAS bf16_t*)F.lds;
    LAS bf16_t* VS = KD + 128 * 136;
    LAS bf16_t* ST = VS + 128 * 136;
    const float l2g = ret_log2_gamma(h);
    const float g128 = exp2f(l2g * 128.f);
    const int we = w >> 2, wd = w & 3;
    const int r0 = tid >> 4, ch = tid & 15;
    float ksc[4];
#pragma unroll
    for (int i = 0; i < 4; ++i) ksc[i] = exp2f(l2g * (float)(127 - (r0 + 32 * i)));
    f32x4 S[4][2];
#pragma unroll
    for (int m = 0; m < 4; ++m) { S[m][0] = (f32x4){0.f, 0.f, 0.f, 0.f}; S[m][1] = S[m][0]; }
    const bf16_t* kp = P1 + ((size_t)b * SEQ + r0) * N3 + C_K + h * 256 + db * 128 + 8 * ch;
    const bf16_t* vp = P1 + ((size_t)b * SEQ + r0) * N3 + C_V + h * 512 + eb * 128 + 8 * ch;
    u32x4 kr[4], vr[4];
#pragma unroll
    for (int i = 0; i < 4; ++i) { kr[i] = *(const u32x4*)(kp + (size_t)(32 * i) * N3); vr[i] = *(const u32x4*)(vp + (size_t)(32 * i) * N3); }
    for (int c = 0; c < 32; ++c) {
#pragma unroll
        for (int i = 0; i < 4; ++i) { const float sc = ksc[i]; u32x4 o;
            o.x = pk2_hw(bflo(kr[i].x) * sc, bfhi(kr[i].x) * sc); o.y = pk2_hw(bflo(kr[i].y) * sc, bfhi(kr[i].y) * sc); o.z = pk2_hw(bflo(kr[i].z) * sc, bfhi(kr[i].z) * sc); o.w = pk2_hw(bflo(kr[i].w) * sc, bfhi(kr[i].w) * sc);
            *(LAS u32x4*)(KD + (r0 + 32 * i) * 136 + 8 * ch) = o; *(LAS u32x4*)(VS + (r0 + 32 * i) * 136 + 8 * ch) = vr[i]; }
        if (c + 1 < 32) { kp += (size_t)128 * N3; vp += (size_t)128 * N3;
#pragma unroll
            for (int i = 0; i < 4; ++i) { kr[i] = *(const u32x4*)(kp + (size_t)(32 * i) * N3); vr[i] = *(const u32x4*)(vp + (size_t)(32 * i) * N3); } }
#pragma unroll
        for (int m = 0; m < 4; ++m)
#pragma unroll
            for (int n = 0; n < 2; ++n)
#pragma unroll
                for (int r = 0; r < 4; ++r) ST[(64 * we + 16 * m + 4 * g + r) * 136 + 32 * wd + 16 * n + i15] = (bf16_t)f2bf_hw(S[m][n][r]);
        __syncthreads();
        { bf16_t* dst = SPR + ((size_t)(bh * 32 + c) * 512 + eb * 128 + r0) * 256 + db * 128 + 8 * ch;
#pragma unroll
          for (int i = 0; i < 4; ++i) *(u32x4*)(dst + (size_t)(32 * i) * 256) = *(const LAS u32x4*)(ST + (r0 + 32 * i) * 136 + 8 * ch); }
        { f32x4 nw[4][2];
#pragma unroll
          for (int m = 0; m < 4; ++m) { nw[m][0] = (f32x4){0.f, 0.f, 0.f, 0.f}; nw[m][1] = nw[m][0]; }
#pragma unroll
          for (int ks = 0; ks < 4; ++ks) { const bf16x8 b0 = frag_tr(KD, 136, 32 * wd, 32 * ks, lane), b1 = frag_tr(KD, 136, 32 * wd + 16, 32 * ks, lane);
#pragma unroll
              for (int m = 0; m < 4; ++m) { const bf16x8 a = frag_tr(VS, 136, 64 * we + 16 * m, 32 * ks, lane); nw[m][0] = MFMA16(a, b0, nw[m][0]); nw[m][1] = MFMA16(a, b1, nw[m][1]); } }
#pragma unroll
          for (int m = 0; m < 4; ++m) { S[m][0] = S[m][0] * g128 + nw[m][0]; S[m][1] = S[m][1] * g128 + nw[m][1]; } }
        __syncthreads();
    }
    { float* rp = A.out + O_RP + ((size_t)bh * 256 + db * 128 + 32 * wd + i15) * 512 + eb * 128 + 64 * we + 4 * g;
#pragma unroll
      for (int m = 0; m < 4; ++m) { *(f32x4*)(rp + 16 * m) = S[m][0]; *(f32x4*)(rp + (size_t)16 * 512 + 16 * m) = S[m][1]; } }
}

__device__ __forceinline__ void ret_out_item(const Frame& F, const Args& A, int it) {
    const int bh = it >> 5, c = it & 31, b = bh >> 3, h = bh & 7;
    const int tid = F.tid, lane = F.lane, w = F.wave, g = lane >> 4, i15 = lane & 15;
    const bf16_t* P1 = (const bf16_t*)(A.ws + WS_P1);
    const bf16_t* SPR = (const bf16_t*)(A.ws + WS_SPR);
    bf16_t* RO = (bf16_t*)(A.ws + WS_RO);
    LAS bf16_t* KQ = (LAS bf16_t*)F.lds;
    LAS bf16_t* AM = KQ + 128 * 264;
    LAS bf16_t* VS = AM + 128 * 136;
    LAS float* RS = (LAS float*)(VS + 128 * 136);
    const float l2g = ret_log2_gamma(h);
    const size_t row0 = (size_t)b * SEQ + c * 128;
    { u32x4 kr[8];
      int tq = tid; asm volatile("" : "+v"(tq));
      const bf16_t* kp = P1 + (row0 + (tq >> 5)) * N3 + C_K + h * 256 + 8 * (tq & 31);
#pragma unroll
      for (int i = 0; i < 8; ++i) kr[i] = *(const u32x4*)(kp + (size_t)i * 16 * N3);
#pragma unroll
      for (int i = 0; i < 8; ++i) { const int idx = tid + NTHREADS * i, r = idx >> 5, ch = idx & 31; *(LAS u32x4*)(KQ + r * 264 + 8 * ch) = kr[i]; } }
    bf16x8 aq[8];
    { const bf16_t* qsrc = P1 + (row0 + 16 * w + i15) * N3 + C_Q + h * 256 + 8 * g;
#pragma unroll
      for (int ks = 0; ks < 8; ++ks) aq[ks] = *(const bf16x8*)(qsrc + 32 * ks); }
    __syncthreads();
#pragma unroll 1
    for (int st = 0; st < 8; ++st) {
        f32x4 sa = (f32x4){0.f, 0.f, 0.f, 0.f};
        if (st <= w) {
#pragma unroll
            for (int ks = 0; ks < 8; ++ks) sa = MFMA16(aq[ks], frag_nat(KQ, 264, 16 * st, 32 * ks, lane), sa);
        }
#pragma unroll
        for (int r = 0; r < 4; ++r) { const int t = 16 * w + 4 * g + r, s2 = 16 * st + i15;
            AM[t * 136 + s2] = (bf16_t)f2bf_hw(s2 <= t ? sa[r] * exp2f(l2g * (float)(t - s2)) : 0.f); }
    }
    __syncthreads();
    { u32x4 qr[8];
      int tq = tid; asm volatile("" : "+v"(tq));
      const bf16_t* qp = P1 + (row0 + (tq >> 5)) * N3 + C_Q + h * 256 + 8 * (tq & 31);
#pragma unroll
      for (int i = 0; i < 8; ++i) qr[i] = *(const u32x4*)(qp + (size_t)i * 16 * N3);
#pragma unroll
      for (int i = 0; i < 8; ++i) { const int idx = tid + NTHREADS * i, r = idx >> 5, ch = idx & 31; const float qs = exp2f(l2g * (float)(r + 1)); const u32x4 x = qr[i]; u32x4 o;
          o.x = pk2_hw(bflo(x.x) * qs, bfhi(x.x) * qs); o.y = pk2_hw(bflo(x.y) * qs, bfhi(x.y) * qs); o.z = pk2_hw(bflo(x.z) * qs, bfhi(x.z) * qs); o.w = pk2_hw(bflo(x.w) * qs, bfhi(x.w) * qs);
          *(LAS u32x4*)(KQ + r * 264 + 8 * ch) = o; } }
    const int wt = w >> 2, we = w & 3;
    f32x4 acc[4][4][2];
#pragma unroll
    for (int eq = 0; eq < 4; ++eq)
#pragma unroll
        for (int m = 0; m < 4; ++m) { acc[eq][m][0] = (f32x4){0.f, 0.f, 0.f, 0.f}; acc[eq][m][1] = acc[eq][m][0]; }
    u32x4 vpre[4];
    { int tq = tid; asm volatile("" : "+v"(tq));
      const bf16_t* vp = P1 + (row0 + (tq >> 4)) * N3 + C_V + h * 512 + 8 * (tq & 15);
#pragma unroll
      for (int i = 0; i < 4; ++i) vpre[i] = *(const u32x4*)(vp + (size_t)i * 32 * N3); }
#pragma unroll
    for (int eq = 0; eq < 4; ++eq) {
#pragma unroll
        for (int i = 0; i < 4; ++i) { const int idx = tid + NTHREADS * i, r = idx >> 4, ch = idx & 15; *(LAS u32x4*)(VS + r * 136 + 8 * ch) = vpre[i]; }
        bf16x8 sb[8];
        int ln = lane; asm volatile("" : "+v"(ln));
        const bf16_t* sp = SPR + ((size_t)(bh * 32 + c) * 512 + eq * 128 + 32 * we + (ln & 15)) * 256 + 8 * (ln >> 4);
#pragma unroll
        for (int j = 0; j < 4; ++j) { sb[2 * j] = *(const bf16x8*)(sp + 32 * j); sb[2 * j + 1] = *(const bf16x8*)(sp + 16 * 256 + 32 * j); }
        if (eq < 3) { int tq = tid; asm volatile("" : "+v"(tq));
            const bf16_t* vp = P1 + (row0 + (tq >> 4)) * N3 + C_V + h * 512 + (eq + 1) * 128 + 8 * (tq & 15);
#pragma unroll
            for (int i = 0; i < 4; ++i) vpre[i] = *(const u32x4*)(vp + (size_t)i * 32 * N3); }
        __syncthreads();
#pragma unroll 1
        for (int ks = 0; ks < 2 * (wt + 1); ++ks) { const bf16x8 b0 = frag_tr(VS, 136, 32 * we, 32 * ks, lane), b1 = frag_tr(VS, 136, 32 * we + 16, 32 * ks, lane);
#pragma unroll
            for (int m = 0; m < 4; ++m) { if (32 * ks <= 64 * wt + 16 * m + 15) { const bf16x8 a = frag_nat(AM, 136, 64 * wt + 16 * m, 32 * ks, lane);
                acc[eq][m][0] = MFMA16(a, b0, acc[eq][m][0]); acc[eq][m][1] = MFMA16(a, b1, acc[eq][m][1]); } } }
#pragma unroll 1
        for (int ks = 0; ks < 8; ++ks) {
#pragma unroll
            for (int m = 0; m < 4; ++m) { const bf16x8 a = frag_nat(KQ, 264, 64 * wt + 16 * m, 32 * ks, lane);
                acc[eq][m][0] = MFMA16(a, sb[0], acc[eq][m][0]); acc[eq][m][1] = MFMA16(a, sb[1], acc[eq][m][1]); }
#pragma unroll
            for (int j = 0; j < 6; ++j) sb[j] = sb[j + 2];
            if (ks + 4 < 8) { sb[6] = *(const bf16x8*)(sp + 32 * (ks + 4)); sb[7] = *(const bf16x8*)(sp + 16 * 256 + 32 * (ks + 4)); }
        }
        __syncthreads();
    }
#pragma unroll
    for (int m = 0; m < 4; ++m)
#pragma unroll
        for (int r = 0; r < 4; ++r) { float ss = 0.f;
#pragma unroll
            for (int eq = 0; eq < 4; ++eq) ss += acc[eq][m][0][r] * acc[eq][m][0][r] + acc[eq][m][1][r] * acc[eq][m][1][r];
            ss = red16_sum(ss); if (i15 == 0) RS[we * 128 + 64 * wt + 16 * m + 4 * g + r] = ss; asm volatile("" ::: "memory"); }
    __syncthreads();
    LAS bf16_t* OS = (LAS bf16_t*)F.lds;
    { float rg[4][2];
#pragma unroll
      for (int eq = 0; eq < 4; ++eq) { rg[eq][0] = A.in[I_RTG][eq * 128 + 32 * we + i15]; rg[eq][1] = A.in[I_RTG][eq * 128 + 32 * we + 16 + i15]; }
#pragma unroll
      for (int m = 0; m < 4; ++m)
#pragma unroll
          for (int r = 0; r < 4; ++r) { const int t = 64 * wt + 16 * m + 4 * g + r;
              const float rr = rsqrtf((RS[t] + RS[128 + t] + RS[256 + t] + RS[384 + t]) * (1.f / 512.f) + EPS);
#pragma unroll
              for (int eq = 0; eq < 4; ++eq) { OS[t * 520 + eq * 128 + 32 * we + i15] = (bf16_t)f2bf_hw(acc[eq][m][0][r] * rr * rg[eq][0]); OS[t * 520 + eq * 128 + 32 * we + 16 + i15] = (bf16_t)f2bf_hw(acc[eq][m][1][r] * rr * rg[eq][1]); }
              asm volatile("" ::: "memory"); } }
    int tq2 = tid; asm volatile("" : "+v"(tq2));
    u32x4 gva[16];
#pragma unroll
    for (int i = 0; i < 16; ++i) { const int idx = tq2 + NTHREADS * i, t = idx >> 6, ch = idx & 63; gva[i] = *(const u32x4*)(P1 + (row0 + t) * N3 + C_G + h * 512 + 8 * ch); }
    __syncthreads();
#pragma unroll
    for (int i = 0; i < 16; ++i) { const int idx = tq2 + NTHREADS * i, t = idx >> 6, ch = idx & 63;
        const u32x4 ov = *(const LAS u32x4*)(OS + t * 520 + 8 * ch);
        const u32x4 gv = gva[i];
        u32x4 o;
        o.x = pk2_hw(bflo(ov.x) * bflo(gv.x), bfhi(ov.x) * bfhi(gv.x)); o.y = pk2_hw(bflo(ov.y) * bflo(gv.y), bfhi(ov.y) * bfhi(gv.y));
        o.z = pk2_hw(bflo(ov.z) * bflo(gv.z), bfhi(ov.z) * bfhi(gv.z)); o.w = pk2_hw(bflo(ov.w) * bflo(gv.w), bfhi(ov.w) * bfhi(gv.w));
        *(u32x4*)(RO + (row0 + t) * KO1 + h * 512 + 8 * ch) = o; }
}

#ifndef MK_N_LAUNCHES
#define MK_N_LAUNCHES 1
#endif
constexpr int NPH = 13;
constexpr int RET_S9 = 512;
constexpr int RET_S10 = 1024;
#ifndef PG8_SP2
#define PG8_SP2 true
#endif
#ifndef PG8_ALIGN
#define PG8_ALIGN true
#endif

__global__ void __launch_bounds__(NTHREADS, 2) mega_fwd(Args args) {
    extern __shared__ __attribute__((aligned(16))) unsigned char lds_raw[];
    Frame F;
    F.lds = (LAS unsigned char*)lds_raw + LDS_SCR;
    F.MISC = (volatile LAS unsigned*)((LAS unsigned char*)lds_raw + LDS_MISC);
    F.tid = threadIdx.x; F.lane = F.tid & 63; F.wave = __builtin_amdgcn_readfirstlane(F.tid >> 6);
    F.G = gridDim.x;
    if (F.tid < 64) F.MISC[F.tid] = 0u;
    __syncthreads();
    unsigned* ctl = (unsigned*)(args.ws + WS_CTL);
    XcdBarrier bar; bar.bar = ctl + CW_BAR; bar.x = 0; bar.st = nullptr;
    const int lo = args.ph_lo, hi = args.ph_hi & 255, qmask = (args.ph_hi >> 8) ? (args.ph_hi >> 8) : 255;
    if (hi - lo > 1) bar = xcd_barrier_post(ctl + CW_BAR, F.MISC + 8);
#ifndef PH_MASK
#define PH_MASK 0x1fff
#endif
#define IN(k) (((PH_MASK >> (k)) & 1) && lo <= (k) && (k) < hi)
#define SEAM(k) do { if (IN(k) && IN((k) + 1)) xcd_barrier(bar); } while (0)
    unsigned char* ws = args.ws;

    if (IN(0)) { p1_mods(F, args); __syncthreads(); p0_prologue(F, args); }
    SEAM(0);
    if (IN(1)) { mods_reduce(F, args); } SEAM(1);
    if (IN(2)) { norm_phase(F, args, 0); } SEAM(2);
    if (IN(3)) {
        pg8::Gemm g{(const bf16_t*)(ws + WS_H), (const bf16_t*)(ws + WS_WT1), MROWS, N1P, DM}; pg8::StaticOrder S; S.init(MROWS, N1P, F.G, (int)blockIdx.x);
        EpiP0 E{(bf16_t*)(ws + WS_P0), (float*)(ws + WS_LR)};
        pg8::gemm_phase<EpiP0, pg8::StaticOrder, PG8_ALIGN, PG8_SP2>(F.lds, g, S, E);
    } SEAM(3);
    if (IN(4)) {
        if ((qmask & 1) && (int)blockIdx.x < 64 && F.G >= 64) gla_state_item(F, args, ((int)blockIdx.x & 7) * 8 + ((int)blockIdx.x >> 3));
        else if ((qmask & 1) && F.G < 64) for (int it = blockIdx.x; it < 64; it += F.G) { gla_state_item(F, args, it); __syncthreads(); }
        if (qmask & 2) for (;;) { const int it = next_item(F, ctl + CW_Q0 + 128); if (it >= 128) break; swa_prompt_item(F, args, it); }
        if (qmask & 4) for (;;) { const int it = next_item(F, ctl + CW_Q0 + 192); if (it >= 256) break; swa_sample_item(F, args, it); }
        if (qmask & 8) for (;;) { const int it = next_item(F, ctl + CW_Q0 + 256); if (it >= 512) break; gla_sample_item(F, args, it); }
        if (qmask & 16) tr_queue(F, args, ctl + CW_Q0 + 448);
    } SEAM(4);
    if (IN(5)) {
        for (int it = blockIdx.x; it < 512; it += F.G) { gla_out_item(F, args, it); __syncthreads(); }
    } SEAM(5);
    if (IN(6)) {
        pg8::Gemm g{(const bf16_t*)(ws + WS_MIX), (const bf16_t*)(ws + WS_WT2), TP, DM, DM}; pg8::StaticOrder S; S.init(TP, DM, F.G, (int)blockIdx.x);
        EpiY1 E{args.in[I_XP], (const float*)(ws + WS_MOD0), (bf16_t*)(ws + WS_Y1)};
        pg8::gemm_phase<EpiY1, pg8::StaticOrder, PG8_ALIGN, PG8_SP2>(F.lds, g, S, E);
        mini_gemm_sample<true>(F, (const bf16_t*)(ws + WS_MIX) + (size_t)TP * DM, (const bf16_t*)(ws + WS_WT2), DM, args.in[I_XS], (const float*)(ws + WS_MOD0), ws + WS_Y1);
    } SEAM(6);
    if (IN(7)) { norm_phase(F, args, 1); } SEAM(7);
    if (IN(8)) {
        pg8::Gemm g{(const bf16_t*)(ws + WS_H), (const bf16_t*)(ws + WS_WT3), MROWS, N3, DM}; pg8::StaticOrder S; S.init(MROWS, N3, F.G, (int)blockIdx.x);
        EpiP1 E{(bf16_t*)(ws + WS_P1), (const f32x2*)(ws + WS_ROT)};
        pg8::gemm_phase<EpiP1, pg8::StaticOrder, PG8_ALIGN, PG8_SP2>(F.lds, g, S, E);
        { const int nfull = (MROWS / 256) * (N3 / 256) - 6 * F.G;
          if (nfull >= 0 && nfull < F.G && (int)blockIdx.x >= nfull) wt4_transposes(F, args, nfull);
          else if (nfull < 0 || nfull >= F.G) wt4_transposes(F, args, 0); }
    } SEAM(8);
    if (IN(9)) {
        if ((qmask & 1) && (int)blockIdx.x < 128 && F.G >= 128) { const int x = (int)blockIdx.x & 7, j = (int)blockIdx.x >> 3; ret_state_item(F, args, (2 * x + (j >> 3)) * 8 + (j & 7)); }
        else if ((qmask & 1) && F.G < 128) for (int it = blockIdx.x; it < 128; it += F.G) { ret_state_item(F, args, it); __syncthreads(); }
        if (qmask & 2) for (;;) { const int it = next_item(F, ctl + CW_Q0 + 384); if (it >= RET_S9) break; ret_sample_item(F, args, it); }
    } SEAM(9);
    if (IN(10)) {
        const bool stream_first = (((int)blockIdx.x >> 3) & 1) == 0;
        if (stream_first) { for (int it = RET_S9 + (int)blockIdx.x; it < RET_S10; it += F.G) { ret_sample_item(F, args, it); __syncthreads(); } }
        for (int it = blockIdx.x; it < 512; it += F.G) { ret_out_item(F, args, it); __syncthreads(); }
        if (!stream_first) { for (int it = RET_S9 + (int)blockIdx.x; it < RET_S10; it += F.G) { ret_sample_item(F, args, it); __syncthreads(); } }
    } SEAM(10);
    if (IN(11)) {
        const bool tile_first = (((int)blockIdx.x >> 3) & 1) == 0;
        if (!tile_first) { for (int it = RET_S10 + (int)blockIdx.x; it < 1024; it += F.G) { __syncthreads(); ret_sample_item(F, args, it); } __syncthreads(); }
        { pg8::Gemm g{(const bf16_t*)(ws + WS_RO), (const bf16_t*)(ws + WS_WT4), TP, DM, KO1}; pg8::StaticOrder S; S.init(TP, DM, F.G, (int)blockIdx.x);
          EpiOut E{(const bf16_t*)(ws + WS_Y1), (const float*)(ws + WS_MOD1), args.out + O_Y};
          pg8::gemm_phase<EpiOut, pg8::StaticOrder, PG8_ALIGN, PG8_SP2>(F.lds, g, S, E); }
        if (tile_first) { for (int it = RET_S10 + (int)blockIdx.x; it < 1024; it += F.G) { __syncthreads(); ret_sample_item(F, args, it); } __syncthreads(); }
        static_assert(RET_S10 == 1024, "the sample rows' GEMM4 rides in phase 11 only if no sample-state item is left for this phase");
        __syncthreads();
        mini_gemm_sample<false>(F, (const bf16_t*)(ws + WS_RO) + (size_t)TP * KO1, (const bf16_t*)(ws + WS_WT4), KO1, (const bf16_t*)(ws + WS_Y1) + (size_t)TP * DM, (const float*)(ws + WS_MOD1), args.out + O_Y);
    }
    if (IN(12)) { }
#undef IN
#undef SEAM
}

extern "C" void kernel_launch(void* const* d_in, const int* in_sizes, int n_in, void* d_out, int out_size, void* d_ws, size_t ws_size, hipStream_t stream) {
    static int grid = 0;
    if (grid == 0) {
        if (n_in != N_IN || (size_t)out_size != O_END || ws_size < WS_END) { fprintf(stderr, "kernel_launch: unexpected shapes: n_in %d out %d ws %zu\n", n_in, out_size, ws_size); grid = -1; return; }
        int dev = 0, cus = 0, per_cu = 0;
        if (hipGetDevice(&dev) != hipSuccess || hipDeviceGetAttribute(&cus, hipDeviceAttributeMultiprocessorCount, dev) != hipSuccess) { grid = -1; return; }
        if (hipFuncSetAttribute((const void*)mega_fwd, hipFuncAttributeMaxDynamicSharedMemorySize, LDS_BYTES) != hipSuccess) { fprintf(stderr, "kernel_launch: hipFuncSetAttribute failed\n"); grid = -1; return; }
        if (hipOccupancyMaxActiveBlocksPerMultiprocessor(&per_cu, (const void*)mega_fwd, NTHREADS, LDS_BYTES) != hipSuccess || per_cu < 1) { fprintf(stderr, "kernel_launch: occupancy query says %d\n", per_cu); per_cu = 1; }
        (void)hipGetLastError();
        grid = cus;
    }
    if (grid < 0) return;
    (void)hipMemsetAsync((char*)d_ws + WS_CTL, 0, CTL_ZERO_BYTES, stream);
    Args a{};
    for (int i = 0; i < N_IN; ++i) a.in[i] = (const float*)d_in[i];
    a.out = (float*)d_out; a.ws = (unsigned char*)d_ws;
#if MK_N_LAUNCHES == 1
    a.ph_lo = 0; a.ph_hi = NPH;
    { void* kargs[] = {&a};
      hipError_t e = hipLaunchCooperativeKernel((const void*)mega_fwd, dim3(grid), dim3(NTHREADS), kargs, LDS_BYTES, stream);
      if (e != hipSuccess) fprintf(stderr, "kernel_launch: cooperative launch failed: %s (grid %d)\n", hipGetErrorString(e), grid); }
#ifdef PROBE_PHASE
#ifndef PROBE_QMASK
#define PROBE_QMASK 0
#endif
    (void)hipMemsetAsync((char*)d_ws + WS_CTL, 0, CTL_ZERO_BYTES, stream);
    a.ph_lo = PROBE_PHASE; a.ph_hi = (PROBE_PHASE + 1) | (PROBE_QMASK << 8);
    hipLaunchKernelGGL(mega_fwd, dim3(grid), dim3(NTHREADS), LDS_BYTES, stream, a);
#endif
#else
    for (int p = 0; p < NPH; ++p) { a.ph_lo = p; a.ph_hi = p + 1;
        hipLaunchKernelGGL(mega_fwd, dim3(grid), dim3(NTHREADS), LDS_BYTES, stream, a);
        hipError_t e = hipPeekAtLastError(); if (e != hipSuccess) { fprintf(stderr, "kernel_launch: launch %d failed: %s\n", p, hipGetErrorName(e)); break; } }
#endif
}
```

```cpp
#include <hip/hip_runtime.h>
#include <cstdio>
#include <cstdint>

#define LAS __attribute__((address_space(3)))
#define GAS __attribute__((address_space(1)))
typedef unsigned short bf16_t;
typedef short bf16x8 __attribute__((ext_vector_type(8)));
typedef short s16x4 __attribute__((ext_vector_type(4)));
typedef float f32x4 __attribute__((ext_vector_type(4)));
typedef float f32x2 __attribute__((ext_vector_type(2)));
typedef unsigned u32x4 __attribute__((ext_vector_type(4)));
typedef unsigned u32x2 __attribute__((ext_vector_type(2)));

namespace pg8 {
constexpr int BM = 256, BK = 64, HALF = 128, HTB = HALF * BK * 2  , STAGE_BYTES = 8 * HTB, NXCD = 8, WGM = 8;

__host__ __device__ __forceinline__ int lds_byte(int r, int c) { const int st = (r >> 4) * 2 + (c >> 5), rr = r & 15, cc = c & 31, ob = rr * 64 + cc * 2; return st * 1024 + (ob ^ (((ob >> 9) & 1) << 5)); }
__host__ __device__ __forceinline__ void stage_rc(int b, int& R, int& C) { const int st = b / 1024, sb = b % 1024, swz = sb ^ (((sb >> 9) & 1) << 5); R = (st >> 1) * 16 + swz / 64; C = (st & 1) * 32 + (swz % 64) / 2; }
__host__ __device__ __forceinline__ int perm32(int rho) { const int n = rho >> 4, i = rho & 15; return 8 * (i >> 2) + 4 * n + (i & 3); }

struct Unit { int pm, pn; };
struct Gemm { const bf16_t* A; const bf16_t* Bt; int M, N, K; };

struct StaticOrder {
    int nM, nN, nwg, G, c;
    __host__ __device__ void init(int M, int N, int G_, int c_) { nM = M / BM; nN = N / BM; nwg = nM * nN; G = G_; c = c_; }
    __host__ __device__ bool next(int i, Unit& u) const {
        const long L = (long)i * G + c; if (L >= nwg) return false;
        int wgid = (int)L; { const int q = nwg / NXCD, r = nwg % NXCD, xcd = wgid % NXCD, off = wgid / NXCD; wgid = (xcd < r ? xcd * (q + 1) : r * (q + 1) + (xcd - r) * q) + off; }
        const int nig = WGM * nN, gid = wgid / nig, fm = gid * WGM, gsz = (nM - fm) < WGM ? (nM - fm) : WGM;
        u.pm = fm + ((wgid % nig) % gsz); u.pn = (wgid % nig) / gsz; return true;
    }
    __device__ __forceinline__ void a_ready(const Unit&) const {}
    __device__ __forceinline__ void done(const Unit&) const {}
};

__device__ __forceinline__ unsigned cvt_pk_bf16(float lo, float hi) { unsigned r; asm volatile("v_cvt_pk_bf16_f32 %0, %1, %2" : "=v"(r) : "v"(lo), "v"(hi)); return r; }

template <class Epi, class Sched, bool ALIGN_EPI = false, bool SP2 = false>
__device__ __forceinline__ void gemm_phase(LAS unsigned char* lds, const Gemm g, const Sched& S, const Epi& E) {
    const int tid = threadIdx.x, wid = __builtin_amdgcn_readfirstlane(tid >> 6), lane = tid & 63, wr = wid >> 2, wc = wid & 3, fr = lane & 15, fq = lane >> 4;
    const int K = g.K, nt = K / BK;
    unsigned voffA[2], voffB[2];
#pragma unroll
    for (int i = 0; i < 2; ++i) { int R, C; stage_rc(tid * 16 + i * 8192, R, C); const int Rb = Epi::PERM ? ((R & ~31) + perm32(R & 31)) : R;
        voffA[i] = (unsigned)(R * K + C) * 2u; voffB[i] = (unsigned)(Rb * K + C) * 2u; }
    const size_t kstep = (size_t)(BK * 2);
    const size_t hstep = (size_t)HALF * K * 2;
    const size_t tstep = 2 * hstep;
    const unsigned ldsw = (unsigned)wid * 1024u;
    const int aoff = lds_byte(wr * 64 + fr, fq * 8), boff = lds_byte(wc * 32 + fr, fq * 8);
#define PG8_SA(b, h) (((b) * 2 + (h)) * HTB)
#define PG8_SB(b, h) ((4 + (b) * 2 + (h)) * HTB)
#define PG8_STAGE(bufoff, gbase, voff) do { _Pragma("unroll") for (int _i = 0; _i < 2; ++_i) \
        __builtin_amdgcn_global_load_lds((const unsigned*)((const char*)(gbase) + (voff)[_i]), (LAS unsigned*)(lds + (bufoff) + ldsw + _i * 8192), 16, 0, 0); } while (0)
#define PG8_LDA(dst, b, h) do { _Pragma("unroll") for (int m = 0; m < 4; ++m) _Pragma("unroll") for (int k = 0; k < 2; ++k) dst[m][k] = *(const LAS bf16x8*)(lds + PG8_SA(b, h) + aoff + m * 2048 + k * 1024); } while (0)
#define PG8_LDB(dst, b, h) do { _Pragma("unroll") for (int n = 0; n < 2; ++n) _Pragma("unroll") for (int k = 0; k < 2; ++k) dst[n][k] = *(const LAS bf16x8*)(lds + PG8_SB(b, h) + boff + n * 2048 + k * 1024); } while (0)
#define PG8_MMA(ai, bj, At, Bt) do { __builtin_amdgcn_s_setprio(1); _Pragma("unroll") for (int m = 0; m < 4; ++m) _Pragma("unroll") for (int n = 0; n < 2; ++n) _Pragma("unroll") for (int k = 0; k < 2; ++k) \
        acc[ai][bj][m][n] = __builtin_amdgcn_mfma_f32_16x16x32_bf16(Bt[n][k], At[m][k], acc[ai][bj][m][n], 0, 0, 0); __builtin_amdgcn_s_setprio(0); } while (0)
#define PG8_WAIT_V(n) asm volatile("s_waitcnt vmcnt(" #n ")" ::: "memory")
#define PG8_WAIT_L(n) asm volatile("s_waitcnt lgkmcnt(" #n ")" ::: "memory")
#define PG8_BAR __builtin_amdgcn_s_barrier()
#define PG8_SCHED __builtin_amdgcn_sched_barrier(0)
    Unit cur, nxt; int ui = 0;
    if (!S.next(0, cur)) return;
    f32x4 acc[2][2][4][2];
#pragma unroll
    for (int a = 0; a < 2; ++a)
#pragma unroll
        for (int b = 0; b < 2; ++b)
#pragma unroll
            for (int m = 0; m < 4; ++m)
#pragma unroll
                for (int n = 0; n < 2; ++n) acc[a][b][m][n] = (f32x4){0.f, 0.f, 0.f, 0.f};
    bf16x8 At[4][2], B0[2][2], B1[2][2];
    const char* cA = (const char*)g.A + (size_t)cur.pm * tstep; const char* cB = (const char*)g.Bt + (size_t)cur.pn * tstep;
    S.a_ready(cur);
    if constexpr (SP2) {
        PG8_STAGE(PG8_SB(0, 0), cB, voffB); PG8_STAGE(PG8_SB(0, 1), cB + hstep, voffB); PG8_STAGE(PG8_SA(0, 0), cA, voffA); PG8_STAGE(PG8_SA(0, 1), cA + hstep, voffA);
        if (wr == 1) PG8_BAR;
        PG8_WAIT_V(2); PG8_BAR;
        PG8_STAGE(PG8_SB(1, 0), cB + kstep, voffB); PG8_STAGE(PG8_SA(1, 0), cA + kstep, voffA); PG8_STAGE(PG8_SB(1, 1), cB + hstep + kstep, voffB);
        PG8_WAIT_V(6); PG8_BAR;
    } else {
        PG8_STAGE(PG8_SB(0, 0), cB, voffB); PG8_STAGE(PG8_SA(0, 0), cA, voffA); PG8_STAGE(PG8_SB(0, 1), cB + hstep, voffB); PG8_STAGE(PG8_SA(0, 1), cA + hstep, voffA);
        if (wr == 1) PG8_BAR;
        PG8_WAIT_V(4); PG8_BAR;
        PG8_STAGE(PG8_SB(1, 0), cB + kstep, voffB); PG8_STAGE(PG8_SA(1, 0), cA + kstep, voffA); PG8_STAGE(PG8_SB(1, 1), cB + hstep + kstep, voffB);
        PG8_WAIT_V(6); PG8_BAR;
    }
    for (;;) {
        const bool has_next = S.next(ui + 1, nxt);
        const char* nA = has_next ? (const char*)g.A + (size_t)nxt.pm * tstep : cA; const char* nB = has_next ? (const char*)g.Bt + (size_t)nxt.pn * tstep : cB;
        for (int t = 0; t < nt; t += 2) {
            const bool last = (t == nt - 2);
            const char* a1 = cA + (size_t)(t + 1) * kstep;
            const char* a2 = last ? nA : cA + (size_t)(t + 2) * kstep; const char* b2 = last ? nB : cB + (size_t)(t + 2) * kstep;
            const char* a3 = a2 + kstep; const char* b3 = b2 + kstep;
            if (last && has_next) S.a_ready(nxt);
            if constexpr (SP2) {
            PG8_LDB(B0, 0, 0); PG8_LDB(B1, 0, 1); PG8_SCHED; PG8_LDA(At, 0, 0); PG8_STAGE(PG8_SA(1, 1), a1 + hstep, voffA);
            PG8_WAIT_V(8); PG8_WAIT_L(0); PG8_BAR; PG8_MMA(0, 0, At, B0); PG8_MMA(0, 1, At, B1); PG8_BAR; PG8_SCHED;
            PG8_LDA(At, 0, 1); PG8_STAGE(PG8_SB(0, 0), b2, voffB); PG8_STAGE(PG8_SB(0, 1), b2 + hstep, voffB); PG8_STAGE(PG8_SA(0, 0), a2, voffA);
            PG8_WAIT_V(8); PG8_WAIT_L(0); PG8_BAR; PG8_MMA(1, 0, At, B0); PG8_MMA(1, 1, At, B1); PG8_BAR; PG8_SCHED;
            PG8_LDB(B0, 1, 0); PG8_LDB(B1, 1, 1); PG8_SCHED; PG8_LDA(At, 1, 0); PG8_STAGE(PG8_SA(0, 1), a2 + hstep, voffA);
            PG8_WAIT_V(8); PG8_WAIT_L(0); PG8_BAR; PG8_MMA(0, 0, At, B0); PG8_MMA(0, 1, At, B1); PG8_BAR; PG8_SCHED;
            PG8_LDA(At, 1, 1); PG8_STAGE(PG8_SB(1, 0), b3, voffB); PG8_STAGE(PG8_SB(1, 1), b3 + hstep, voffB); PG8_STAGE(PG8_SA(1, 0), a3, voffA);
            PG8_WAIT_V(8); PG8_WAIT_L(0); PG8_BAR; PG8_MMA(1, 0, At, B0); PG8_MMA(1, 1, At, B1); PG8_BAR; PG8_SCHED;
            } else {
            PG8_LDB(B0, 0, 0); PG8_SCHED; PG8_LDA(At, 0, 0); PG8_STAGE(PG8_SA(1, 1), a1 + hstep, voffA);
            PG8_WAIT_L(8); PG8_BAR; PG8_WAIT_L(0); PG8_MMA(0, 0, At, B0); PG8_BAR; PG8_SCHED;
            PG8_LDB(B1, 0, 1); PG8_STAGE(PG8_SB(0, 0), b2, voffB);
            PG8_BAR; PG8_WAIT_L(0); PG8_MMA(0, 1, At, B1); PG8_BAR;
            PG8_LDA(At, 0, 1); PG8_STAGE(PG8_SA(0, 0), a2, voffA);
            PG8_BAR; PG8_WAIT_L(0); PG8_MMA(1, 0, At, B0); PG8_BAR; PG8_SCHED;
            PG8_STAGE(PG8_SB(0, 1), b2 + hstep, voffB);
            PG8_WAIT_V(6); PG8_BAR; PG8_MMA(1, 1, At, B1); PG8_BAR;
            PG8_LDB(B0, 1, 0); PG8_SCHED; PG8_LDA(At, 1, 0); PG8_STAGE(PG8_SA(0, 1), a2 + hstep, voffA);
            PG8_WAIT_L(8); PG8_BAR; PG8_WAIT_L(0); PG8_MMA(0, 0, At, B0); PG8_BAR; PG8_SCHED;
            PG8_LDB(B1, 1, 1); PG8_STAGE(PG8_SB(1, 0), b3, voffB);
            PG8_BAR; PG8_WAIT_L(0); PG8_MMA(0, 1, At, B1); PG8_BAR;
            PG8_LDA(At, 1, 1); PG8_STAGE(PG8_SA(1, 0), a3, voffA);
            PG8_BAR; PG8_WAIT_L(0); PG8_MMA(1, 0, At, B0); PG8_BAR; PG8_SCHED;
            PG8_STAGE(PG8_SB(1, 1), b3 + hstep, voffB);
            PG8_WAIT_V(6); PG8_BAR; PG8_MMA(1, 1, At, B1); PG8_BAR;
            }
        }
        if constexpr (ALIGN_EPI) { if (wr == 0) PG8_BAR; }
        E(acc, cur, wr, wc, fr, fq); S.done(cur);
        if (!has_next) break;
#pragma unroll
        for (int a = 0; a < 2; ++a)
#pragma unroll
            for (int b = 0; b < 2; ++b)
#pragma unroll
                for (int m = 0; m < 4; ++m)
#pragma unroll
                    for (int n = 0; n < 2; ++n) acc[a][b][m][n] = (f32x4){0.f, 0.f, 0.f, 0.f};
        cur = nxt; cA = nA; cB = nB; ++ui;
        if constexpr (ALIGN_EPI) { if (wr == 1) PG8_BAR; }
    }
    PG8_WAIT_V(0);
    if constexpr (!ALIGN_EPI) { if (wr == 0) PG8_BAR; }
    PG8_BAR;
#undef PG8_SA
#undef PG8_SB
#undef PG8_STAGE
#undef PG8_LDA
#undef PG8_LDB
#undef PG8_MMA
#undef PG8_WAIT_V
#undef PG8_WAIT_L
#undef PG8_BAR
#undef PG8_SCHED
}
}

constexpr int NWAVES = 8, NTHREADS = 512;
constexpr int DM = 2048, SEQ = 4096, TP = 8192, TS = 512, MROWS = TP + TS;
constexpr int NBD = 128;
constexpr int N1 = 5376, N1P = 5632, NIN0 = 5392, N3 = 12288, KO1 = 4096;
constexpr int C_QA = 0, C_KA = 1024, C_VA = 1152, C_GA = 1280, C_QB = 2304, C_KB = 2816, C_VB = 3328, C_GB = 4352;
constexpr int C_Q = 0, C_K = 2048, C_V = 4096, C_G = 8192;
constexpr float EPS = 1e-6f;
enum { I_XP = 0, I_XS, I_CK, I_CV, I_SG, I_SR, I_CP, I_CS, I_RB, I_AWE, I_ABE, I_NGE, I_WIE, I_WLR, I_BLR, I_QNG, I_KNG, I_SNK, I_GLG, I_WOE, I_AWO, I_ABO, I_NGO, I_WIO, I_RTG, I_WOO, N_IN };
constexpr size_t O_Y = 0, O_KP = 17825792, O_VP = 17858560, O_GP = 17891328, O_RP = 18153472, O_KS = 20250624, O_VS = 22347776, O_GS = 24444928, O_RS = 41222144, O_END = 175439872;

constexpr size_t MiB = 1u << 20;
constexpr size_t WS_CTL = 0, CTL_ZERO_BYTES = 65536;
constexpr size_t WS_SC = 1 * MiB, WS_MOD0 = 2 * MiB, WS_MOD1 = 6 * MiB, WS_ROT = 10 * MiB, WS_LR = 15 * MiB;
constexpr size_t WS_WT1 = 16 * MiB, WS_WT2 = 38 * MiB, WS_WT3 = 46 * MiB, WS_WT4 = 94 * MiB;
constexpr size_t WS_H = 110 * MiB, WS_P0 = 144 * MiB, WS_MIX = 234 * MiB, WS_Y1 = 268 * MiB, WS_P1 = 336 * MiB, WS_RO = 540 * MiB, WS_SPG = 608 * MiB, WS_SPR = 640 * MiB, WS_END = 768 * MiB;
constexpr int CW_BAR = 1024;
constexpr int CW_Q0 = 8192;

constexpr int LDS_MISC = 0;
constexpr int LDS_SCR = 256;
constexpr int LDS_BYTES = 147456;
constexpr int LDS_SCR_BYTES = LDS_BYTES - LDS_SCR;

#define LDS_WAIT() asm volatile("s_waitcnt lgkmcnt(0)" ::: "memory")
#define VM_WAIT() asm volatile("s_waitcnt vmcnt(0)" ::: "memory")
typedef __bf16 bf16n2 __attribute__((ext_vector_type(2)));
__device__ __forceinline__ unsigned f2bf_hw(float f) { return (unsigned)__builtin_bit_cast(unsigned short, (__bf16)f); }
__device__ __forceinline__ unsigned pk2_hw(float lo, float hi) { const f32x2 v = {lo, hi}; return __builtin_bit_cast(unsigned, __builtin_convertvector(v, bf16n2)); }
__device__ __forceinline__ unsigned f2bf(float f) { unsigned u = __builtin_bit_cast(unsigned, f); return (u + 0x7fffu + ((u >> 16) & 1u)) >> 16; }
__device__ __forceinline__ unsigned pk2(float lo, float hi) { return f2bf(lo) | (f2bf(hi) << 16); }
__device__ __forceinline__ float bf2f(bf16_t b) { return __builtin_bit_cast(float, (unsigned)b << 16); }
__device__ __forceinline__ float bflo(unsigned w) { return __builtin_bit_cast(float, w << 16); }
__device__ __forceinline__ float bfhi(unsigned w) { return __builtin_bit_cast(float, w & 0xffff0000u); }
__device__ __forceinline__ float silu_f(float x) { return x * __builtin_amdgcn_rcpf(1.f + __expf(-x)); }
__device__ __forceinline__ float logsig_f(float z) { return fminf(z, 0.f) - __logf(1.f + __expf(-fabsf(z))); }
__device__ __forceinline__ float wave_sum(float v) {
#pragma unroll
    for (int o = 1; o < 64; o <<= 1) v += __shfl_xor(v, o);
    return v;
}
__device__ __forceinline__ float wave_incl_scan(float v) {
#define WIS_DPP(x, ctrl, rmask) __builtin_bit_cast(float, __builtin_amdgcn_update_dpp(0, __builtin_bit_cast(int, (x)), (ctrl), (rmask), 0xf, false))
    v += WIS_DPP(v, 0x111, 0xf);
    v += WIS_DPP(v, 0x112, 0xf);
    v += WIS_DPP(v, 0x114, 0xf);
    v += WIS_DPP(v, 0x118, 0xf);
    v += WIS_DPP(v, 0x142, 0xa);
    v += WIS_DPP(v, 0x143, 0xc);
#undef WIS_DPP
    return v;
}
__device__ __forceinline__ float red16_sum(float v) { v += __shfl_xor(v, 1); v += __shfl_xor(v, 2); v += __shfl_xor(v, 4); v += __shfl_xor(v, 8); return v; }
__device__ __forceinline__ float red16_max(float v) { v = fmaxf(v, __shfl_xor(v, 1)); v = fmaxf(v, __shfl_xor(v, 2)); v = fmaxf(v, __shfl_xor(v, 4)); v = fmaxf(v, __shfl_xor(v, 8)); return v; }

__device__ __forceinline__ bf16x8 frag_nat(const LAS bf16_t* base, int pitch, int x0, int k0, int lane) {
    return *(const LAS bf16x8*)(base + (x0 + (lane & 15)) * pitch + k0 + 8 * (lane >> 4));
}
__device__ __forceinline__ bf16x8 frag_tr(const LAS bf16_t* base, int pitch, int x0, int k0, int lane) {
    const int g = lane >> 4, i = lane & 15;
    const LAS bf16_t* p = base + (k0 + 8 * g + (i >> 2)) * pitch + x0 + 4 * (i & 3);
    const s16x4 lo = __builtin_amdgcn_ds_read_tr16_b64_v4i16((LAS s16x4*)p);
    const s16x4 hi = __builtin_amdgcn_ds_read_tr16_b64_v4i16((LAS s16x4*)(p + 4 * pitch));
    return (bf16x8){lo[0], lo[1], lo[2], lo[3], hi[0], hi[1], hi[2], hi[3]};
}
#define MFMA16(a, b, c) __builtin_amdgcn_mfma_f32_16x16x32_bf16((a), (b), (c), 0, 0, 0)

#define XB_TMO      128
#define XB_XCNT(j)  (256  + 64 * (j))
#define XB_XSUB(j)  (1280 + 64 * (j))
#define XB_XGEN(j)  (2304 + 64 * (j))
#define XB_TOP      3328
#define XB_TOPGEN   3392
#define XCD_BAR_WORDS 3456
#define XB_SPIN_CAP (1u << 20)
__device__ __forceinline__ unsigned xb_ld(unsigned* p)              { return __hip_atomic_load(p, __ATOMIC_RELAXED, __HIP_MEMORY_SCOPE_AGENT); }
__device__ __forceinline__ unsigned xb_add(unsigned* p, unsigned v) { return __hip_atomic_fetch_add(p, v, __ATOMIC_RELAXED, __HIP_MEMORY_SCOPE_AGENT); }
__device__ __forceinline__ unsigned xb_xcc_id() { return (unsigned)__builtin_amdgcn_s_getreg((3 << 11) | 20) & 0xFu; }
#define XB_SPIN(cond, bar) do { unsigned _sp = 0; while (cond) { __builtin_amdgcn_s_sleep(1); \
    if ((++_sp & 255u) == 0u) { if (xb_ld(&(bar)[XB_TMO])) break; if (_sp > XB_SPIN_CAP) { atomicAdd(&(bar)[XB_TMO], 1u); break; } } } } while (0)
struct XcdBarrier { unsigned* bar; unsigned x; volatile LAS unsigned* st; };
__device__ __forceinline__ XcdBarrier xcd_barrier_post(unsigned* bar, volatile LAS unsigned* st) {
    XcdBarrier b; b.bar = bar; b.x = xb_xcc_id(); b.st = st;
    if (threadIdx.x == 0) (void)xb_add(&bar[XB_XCNT(b.x)], 1u);
    return b;
}
__device__ __forceinline__ void xcd_barrier_complete(unsigned* bar, unsigned x, unsigned& nloc, unsigned& nx) {
    const unsigned G = gridDim.x * gridDim.y * gridDim.z;
    unsigned sum, cnt, mine, sp = 0u;
    for (;;) {
        sum = 0u; cnt = 0u; mine = 0u;
#pragma unroll
        for (unsigned j = 0; j < 16; ++j) { const unsigned c = xb_ld(&bar[XB_XCNT(j)]); sum += c; cnt += (c > 0u) ? 1u : 0u; mine = (j == x) ? c : mine; }
        if (sum == G) break;
        __builtin_amdgcn_s_sleep(1);
        if ((++sp & 255u) == 0u) { if (xb_ld(&bar[XB_TMO])) break; if (sp > XB_SPIN_CAP) { atomicAdd(&bar[XB_TMO], 1u); break; } }
    }
    nloc = mine > 0u ? mine : 1u; nx = cnt > 0u ? cnt : 1u;
}
__device__ __forceinline__ void xcd_barrier(const XcdBarrier& b) {
    asm volatile("s_waitcnt vmcnt(0)" ::: "memory");
    __syncthreads();
    if (threadIdx.x == 0) {
        unsigned* bar = b.bar;
        __builtin_amdgcn_s_waitcnt(0);
        unsigned nloc = b.st[0], nx = b.st[1];
        if (nloc == 0u) { xcd_barrier_complete(bar, b.x, nloc, nx); b.st[0] = nloc; b.st[1] = nx; }
        const unsigned old = xb_add(&bar[XB_XSUB(b.x)], 1u);
        const unsigned gen = old / nloc;
        if (old + 1u == (gen + 1u) * nloc) {
            __builtin_amdgcn_fence(__ATOMIC_RELEASE, "agent");
            asm volatile("s_waitcnt vmcnt(0)" ::: "memory");
            const unsigned og = xb_add(&bar[XB_TOP], 1u);
            const unsigned tg = og / nx;
            if (og + 1u == (tg + 1u) * nx) xb_add(&bar[XB_TOPGEN], 1u);
            else XB_SPIN(xb_ld(&bar[XB_TOPGEN]) == tg, bar);
            __builtin_amdgcn_fence(__ATOMIC_ACQUIRE, "agent");
            xb_add(&bar[XB_XGEN(b.x)], 1u);
            asm volatile("s_waitcnt vmcnt(0)" ::: "memory");
        } else {
            XB_SPIN(xb_ld(&bar[XB_XGEN(b.x)]) == gen, bar);
            __builtin_amdgcn_fence(__ATOMIC_ACQUIRE, "agent");
            asm volatile("s_waitcnt vmcnt(0)" ::: "memory");
        }
    }
    __syncthreads();
}

struct Args { const float* in[N_IN]; float* out; unsigned char* ws; int ph_lo, ph_hi; };
struct Frame {
    LAS unsigned char* lds;
    volatile LAS unsigned* MISC;
    int tid, lane, wave, G;
};
__device__ __forceinline__ int next_item(const Frame& F, unsigned* head) {
    __syncthreads();
    if (F.tid == 0) F.MISC[4] = __hip_atomic_fetch_add(head, 1u, __ATOMIC_RELAXED, __HIP_MEMORY_SCOPE_AGENT);
    __syncthreads();
    return (int)F.MISC[4];
}

struct TrItem { const float* src; bf16_t* dst; int ldw, K; bool ok; };
__device__ __forceinline__ TrItem tr_desc(const float* W, int K, int ldw, int ncol_valid, bf16_t* WT, int kb, int nb, int lane) {
    const int k0 = 64 * kb, n0 = 64 * nb, n4 = n0 + 4 * (lane & 15);
    TrItem d; d.src = W + (size_t)(k0 + (lane >> 4)) * ldw + (n4 < ncol_valid ? n4 : 0)  ; d.dst = WT + (size_t)(n0 + (lane >> 3)) * K + k0 + 8 * (lane & 7); d.ldw = ldw; d.K = K; d.ok = n4 < ncol_valid; return d;
}
__device__ __forceinline__ void tr_load(const TrItem& d, f32x4 (&v)[16]) {
#pragma unroll
    for (int i = 0; i < 16; ++i) v[i] = __builtin_nontemporal_load((const f32x4*)(d.src + (size_t)(4 * i) * d.ldw));
}
__device__ __forceinline__ void tr_finish(const TrItem& d, const f32x4 (&v)[16], LAS float* scr, int lane) {
    const int kr = lane >> 4;
    const float keep = d.ok ? 1.f : 0.f;
#pragma unroll
    for (int i = 0; i < 16; ++i) { LAS float* t = scr + (kr + 4 * i) * 65 + 4 * (lane & 15); t[0] = v[i].x * keep; t[1] = v[i].y * keep; t[2] = v[i].z * keep; t[3] = v[i].w * keep; }
    LDS_WAIT(); asm volatile("" ::: "memory");
    const int c = lane & 7;
#pragma unroll
    for (int j = 0; j < 8; ++j) { const int n = (lane >> 3) + 8 * j; const LAS float* s = scr + (8 * c) * 65 + n;
        u32x4 o; o.x = pk2_hw(s[0 * 65], s[1 * 65]); o.y = pk2_hw(s[2 * 65], s[3 * 65]); o.z = pk2_hw(s[4 * 65], s[5 * 65]); o.w = pk2_hw(s[6 * 65], s[7 * 65]);
        *(u32x4*)(d.dst + (size_t)(8 * j) * d.K) = o; }
    LDS_WAIT(); asm volatile("" ::: "memory");
}
__device__ __forceinline__ TrItem p0_tr_desc(const Args& A, int it, int lane) {
    constexpr int I1 = 32 * 85, I2 = 32 * 32;
    unsigned char* ws = A.ws;
    if (it < I1) return tr_desc(A.in[I_WIE], DM, NIN0, NIN0, (bf16_t*)(ws + WS_WT1), it / 85, it % 85, lane);
    it -= I1;
    if (it < I2) return tr_desc(A.in[I_WOE], DM, DM, DM, (bf16_t*)(ws + WS_WT2), it / 32, it % 32, lane);
    it -= I2;
    return tr_desc(A.in[I_WIO], DM, N3, N3, (bf16_t*)(ws + WS_WT3), it / 192, it % 192, lane);
}
__device__ __forceinline__ void p0_prologue(const Frame& F, const Args& A) {
    unsigned char* ws = A.ws;
    const int gtid = blockIdx.x * NTHREADS + F.tid, NT = F.G * NTHREADS;
    const int gw = blockIdx.x * NWAVES + F.wave, NGW = F.G * NWAVES;
    { f32x2* ROT = (f32x2*)(ws + WS_ROT);
      for (int idx = gtid; idx < 4100 * 128; idx += NT) { const int pi = idx >> 7, d = idx & 127;
          const float pos = (float)(pi < 4096 ? pi : 8192 + (pi - 4096));
          const float inv = powf(10000.f, -(float)d * (1.f / 128.f));
          const double rev = (double)pos * (double)inv * 0.15915494309189535;
          const float fr = (float)(rev - __builtin_floor(rev));
          ROT[idx] = (f32x2){__builtin_amdgcn_cosf(fr), __builtin_amdgcn_sinf(fr)}; } }
    { u32x4* z = (u32x4*)((bf16_t*)(ws + WS_WT1) + (size_t)5440 * DM);
      for (int idx = gtid; idx < 192 * 256; idx += NT) z[idx] = (u32x4){0u, 0u, 0u, 0u}; }
    LAS float* scr = (LAS float*)(F.lds + F.wave * 16640);
    constexpr int NIT = 32 * 85;
    f32x4 va[16], vb[16]; TrItem da, db;
    int it = gw;
    if (it < NIT) { da = p0_tr_desc(A, it, F.lane); tr_load(da, va); }
#pragma unroll 1
    while (it < NIT) {
        const int it1 = it + NGW, it2 = it + 2 * NGW;
        if (it1 < NIT) { db = p0_tr_desc(A, it1, F.lane); tr_load(db, vb); }
        tr_finish(da, va, scr, F.lane);
        if (it1 >= NIT) break;
        if (it2 < NIT) { da = p0_tr_desc(A, it2, F.lane); tr_load(da, va); }
        tr_finish(db, vb, scr, F.lane);
        it = it2;
    }
}
constexpr int TRQ_TICKETS = (32 * 32 + 32 * 192) / 16;
__device__ __forceinline__ void tr_queue(const Frame& F, const Args& A, unsigned* head) {
    LAS float* scr = (LAS float*)(F.lds + F.wave * 16640);
    f32x4 va[16], vb[16];
    for (;;) { const int t = next_item(F, head); if (t >= TRQ_TICKETS) break;
        const int i0 = 32 * 85 + t * 16 + F.wave;
        const TrItem da = p0_tr_desc(A, i0, F.lane); tr_load(da, va);
        const TrItem db = p0_tr_desc(A, i0 + 8, F.lane); tr_load(db, vb);
        tr_finish(da, va, scr, F.lane); tr_finish(db, vb, scr, F.lane); }
}
__device__ __forceinline__ void wt4_transposes(const Frame& F, const Args& A, int blk0) {
    LAS float* scr = (LAS float*)(F.lds + F.wave * 16640);
    const int nw = (F.G - blk0) * NWAVES;
    bf16_t* WT4 = (bf16_t*)(A.ws + WS_WT4);
    f32x4 va[16], vb[16]; TrItem da, db;
    int it = ((int)blockIdx.x - blk0) * NWAVES + F.wave;
    if (it < 64 * 32) { da = tr_desc(A.in[I_WOO], KO1, DM, DM, WT4, it / 32, it % 32, F.lane); tr_load(da, va); }
#pragma unroll 1
    while (it < 64 * 32) {
        const int it1 = it + nw, it2 = it + 2 * nw;
        if (it1 < 64 * 32) { db = tr_desc(A.in[I_WOO], KO1, DM, DM, WT4, it1 / 32, it1 % 32, F.lane); tr_load(db, vb); }
        tr_finish(da, va, scr, F.lane);
        if (it1 >= 64 * 32) break;
        if (it2 < 64 * 32) { da = tr_desc(A.in[I_WOO], KO1, DM, DM, WT4, it2 / 32, it2 % 32, F.lane); tr_load(da, va); }
        tr_finish(db, vb, scr, F.lane);
        it = it2;
    }
}

__device__ __forceinline__ void p1_mods(const Frame& F, const Args& A) {
    LAS bf16_t* tile = (LAS bf16_t*)F.lds;
    LAS bf16_t* scs = tile + 256 * 136;
    const int lane = F.lane, g = lane >> 4, i = lane & 15, w = F.wave, tid = F.tid;
    const int k8 = (int)blockIdx.x & 7, kb = k8 * 256;
    {
        f32x4 cv[9][2];
#pragma unroll
        for (int j = 0; j < 9; ++j) { const int idx = tid + NTHREADS * j, r = idx >> 5, ch = idx & 31, rc = r < 130 ? r : 129;
            const float* cp = (rc < 2 ? A.in[I_CP] + (size_t)rc * DM : A.in[I_CS] + (size_t)(rc - 2) * DM) + kb + 8 * ch; cv[j][0] = *(const f32x4*)cp; cv[j][1] = *(const f32x4*)(cp + 4); }
#pragma unroll
        for (int j = 0; j < 9; ++j) { const int idx = tid + NTHREADS * j, r = idx >> 5, ch = idx & 31; const f32x4 v0 = cv[j][0], v1 = cv[j][1];
            u32x4 o; o.x = pk2_hw(silu_f(v0.x), silu_f(v0.y)); o.y = pk2_hw(silu_f(v0.z), silu_f(v0.w)); o.z = pk2_hw(silu_f(v1.x), silu_f(v1.y)); o.w = pk2_hw(silu_f(v1.z), silu_f(v1.w));
            if (r >= 130) o = (u32x4){0u, 0u, 0u, 0u};
            *(LAS u32x4*)(scs + r * 264 + 8 * ch) = o; }
    }
    const int c4 = lane & 31, r2 = lane >> 5;
    f32x4 wv[16];
#define MODS_LOAD(itx) do { const int _it = (itx) < 768 ? (itx) : (int)blockIdx.x, _layer = _it / 384, _n0 = ((_it % 384) >> 3) * 128; \
        const float* _wp = (_layer ? A.in[I_AWO] : A.in[I_AWE]) + (size_t)(kb + 32 * w + r2) * 6144 + _n0 + 4 * c4; \
        _Pragma("unroll") for (int _j = 0; _j < 16; ++_j) wv[_j] = __builtin_nontemporal_load((const f32x4*)(_wp + (size_t)(2 * _j) * 6144)); } while (0)
    MODS_LOAD((int)blockIdx.x);
    for (int it = blockIdx.x; it < 768; it += F.G) {
        const int layer = it / 384, rem = it % 384, strip = rem >> 3, n0 = strip * 128;
        float* PART = (float*)(A.ws + WS_P1) + (size_t)(k8 * 2 + layer) * 130 * 6144;
#pragma unroll
        for (int j = 0; j < 16; ++j) { u32x2 o; o.x = pk2_hw(wv[j].x, wv[j].y); o.y = pk2_hw(wv[j].z, wv[j].w); *(LAS u32x2*)(tile + (32 * w + r2 + 2 * j) * 136 + 4 * c4) = o; }
        MODS_LOAD(it + F.G);
        __builtin_amdgcn_sched_barrier(0);
        __syncthreads();
        f32x4 acc[9];
#pragma unroll
        for (int m = 0; m < 9; ++m) acc[m] = (f32x4){0.f, 0.f, 0.f, 0.f};
#pragma unroll 2
        for (int ks = 0; ks < 8; ++ks) {
            const bf16x8 b = frag_tr(tile, 136, 16 * w, 32 * ks, lane);
#pragma unroll
            for (int m = 0; m < 9; ++m) acc[m] = MFMA16(frag_nat(scs, 264, 16 * m, 32 * ks, lane), b, acc[m]);
        }
        const int col = n0 + 16 * w + i;
#pragma unroll
        for (int m = 0; m < 9; ++m)
#pragma unroll
            for (int r = 0; r < 4; ++r) { const int row = 16 * m + 4 * g + r; if (row < 130) PART[(size_t)row * 6144 + col] = acc[m][r]; }
        __syncthreads();
    }
#undef MODS_LOAD
}
__device__ __forceinline__ void mods_reduce(const Frame& F, const Args& A) {
    constexpr int PER = 130 * 1536, NV = 2 * PER;
    const f32x4* P = (const f32x4*)(A.ws + WS_P1);
    for (int idx = blockIdx.x * NTHREADS + F.tid; idx < NV; idx += F.G * NTHREADS) {
        const int layer = idx >= PER ? 1 : 0, rem = idx - layer * PER, col4 = rem % 1536;
        f32x4 v[8];
#pragma unroll
        for (int k8 = 0; k8 < 8; ++k8) v[k8] = P[(size_t)(k8 * 2 + layer) * PER + rem];
        f32x4 s = *(const f32x4*)((layer ? A.in[I_ABO] : A.in[I_ABE]) + 4 * col4);
#pragma unroll
        for (int k8 = 0; k8 < 8; ++k8) s += v[k8];
        *(f32x4*)((float*)(A.ws + (layer ? WS_MOD1 : WS_MOD0)) + 4 * (size_t)rem) = s; }
}

__device__ __forceinline__ void norm_row_load(const Args& A, int layer, int row, int lane, f32x4 (&x)[8]) {
    if (layer) { const bf16_t* yr = (const bf16_t*)(A.ws + WS_Y1) + (size_t)row * DM + 4 * lane;
#pragma unroll
        for (int j = 0; j < 8; ++j) { const u32x2 w = *(const u32x2*)(yr + 256 * j); x[j] = (f32x4){bflo(w.x), bfhi(w.x), bflo(w.y), bfhi(w.y)}; } }
    else { const float* xr = (row < TP ? A.in[I_XP] + (size_t)row * DM : A.in[I_XS] + (size_t)(row - TP) * DM) + 4 * lane;
#pragma unroll
        for (int j = 0; j < 8; ++j) x[j] = *(const f32x4*)(xr + 256 * j); }
}
__device__ __forceinline__ void norm_phase(const Frame& F, const Args& A, int layer) {
    const float* MOD = (const float*)(A.ws + (layer ? WS_MOD1 : WS_MOD0));
    const float* gvec = layer ? A.in[I_NGO] : A.in[I_NGE];
    bf16_t* H = (bf16_t*)(A.ws + WS_H);
    const int gw = blockIdx.x * NWAVES + F.wave, NGW = F.G * NWAVES, lane = F.lane;
    f32x4 xn[8];
    if (gw < MROWS) norm_row_load(A, layer, gw, lane, xn);
#pragma unroll 1
    for (int row = gw; row < MROWS; row += NGW) {
        const int b = row < TP ? (row >> 12) : 2 + ((row - TP) >> 2);
        const float* shift = MOD + (size_t)b * 6144; const float* scale = shift + DM;
        f32x4 v[8], gg[8], sc[8], sh[8];
#pragma unroll
        for (int j = 0; j < 8; ++j) { const int c = 4 * lane + 256 * j; v[j] = xn[j]; gg[j] = *(const f32x4*)(gvec + c); sc[j] = *(const f32x4*)(scale + c); sh[j] = *(const f32x4*)(shift + c); }
        if (row + NGW < MROWS) norm_row_load(A, layer, row + NGW, lane, xn);
        __builtin_amdgcn_sched_barrier(0);
        float ss = 0.f;
#pragma unroll
        for (int j = 0; j < 8; ++j) ss += (v[j].x * v[j].x + v[j].y * v[j].y) + (v[j].z * v[j].z + v[j].w * v[j].w);
        const float r = rsqrtf(wave_sum(ss) * (1.f / DM) + EPS);
#pragma unroll
        for (int j = 0; j < 8; ++j) { const int c = 4 * lane + 256 * j;
            const f32x4 h = v[j] * r * gg[j] * (sc[j] + 1.f) + sh[j];
            u32x2 o; o.x = pk2_hw(h.x, h.y); o.y = pk2_hw(h.z, h.w);
            *(u32x2*)(H + (size_t)row * DM + c) = o; }
    }
}

struct EpiP0 {
    static constexpr bool PERM = true;
    bf16_t* P0; float* LR;
    __device__ __forceinline__ void operator()(const f32x4 (&acc)[2][2][4][2], const pg8::Unit& u, int wr, int wc, int fr, int fq) const {
        const int pn = u.pn, row0 = u.pm * 256 + wr * 64 + fr;
        if (pn == 21) {
            if (wc == 0 && fq < 2) {
#pragma unroll
                for (int ai = 0; ai < 2; ++ai)
#pragma unroll
                    for (int m = 0; m < 4; ++m) { float* p = LR + (size_t)(row0 + ai * 128 + m * 16) * 16 + 8 * fq;
                        *(f32x4*)p = acc[ai][0][m][0]; *(f32x4*)(p + 4) = acc[ai][0][m][1]; }
            }
            return;
        }
        const bool do_silu = (pn >= 5 && pn <= 8) || (pn >= 17);
        const float sc = (pn == 9 || pn == 10) ? 0.08838834764831845f : 1.f;
        const int col0 = pn * 256 + wc * 32 + 8 * fq;
#pragma unroll
        for (int ai = 0; ai < 2; ++ai)
#pragma unroll
            for (int m = 0; m < 4; ++m) { bf16_t* rowp = P0 + (size_t)(row0 + ai * 128 + m * 16) * N1 + col0;
#pragma unroll
                for (int bj = 0; bj < 2; ++bj) { f32x4 v0 = acc[ai][bj][m][0] * sc, v1 = acc[ai][bj][m][1] * sc;
                    if (do_silu) {
#pragma unroll
                        for (int j = 0; j < 4; ++j) { v0[j] = silu_f(v0[j]); v1[j] = silu_f(v1[j]); } }
                    u32x4 w; w.x = pg8::cvt_pk_bf16(v0[0], v0[1]); w.y = pg8::cvt_pk_bf16(v0[2], v0[3]); w.z = pg8::cvt_pk_bf16(v1[0], v1[1]); w.w = pg8::cvt_pk_bf16(v1[2], v1[3]);
                    *(u32x4*)(rowp + bj * 128) = w; } }
    }
};
struct EpiY1 {
    static constexpr bool PERM = true;
    const float* base0; const float* mod; bf16_t* out;
    __device__ __forceinline__ void operator()(const f32x4 (&acc)[2][2][4][2], const pg8::Unit& u, int wr, int wc, int fr, int fq) const {
        const int col0 = u.pn * 256 + wc * 32 + 8 * fq;
        const float* gp = mod + (size_t)(u.pm >> 4) * 6144 + 2 * DM + col0;
        f32x4 gt[2][2];
#pragma unroll
        for (int bj = 0; bj < 2; ++bj) { gt[bj][0] = *(const f32x4*)(gp + bj * 128); gt[bj][1] = *(const f32x4*)(gp + bj * 128 + 4); }
#pragma unroll
        for (int ai = 0; ai < 2; ++ai)
#pragma unroll
            for (int mh = 0; mh < 2; ++mh) {
                f32x4 xb[2][2][2];
#pragma unroll
                for (int m2 = 0; m2 < 2; ++m2) { const int row = u.pm * 256 + ai * 128 + wr * 64 + (2 * mh + m2) * 16 + fr; const float* bp = base0 + (size_t)row * DM + col0;
#pragma unroll
                    for (int bj = 0; bj < 2; ++bj) { xb[m2][bj][0] = *(const f32x4*)(bp + bj * 128); xb[m2][bj][1] = *(const f32x4*)(bp + bj * 128 + 4); } }
                __builtin_amdgcn_sched_barrier(0);
#pragma unroll
                for (int m2 = 0; m2 < 2; ++m2) { const int m = 2 * mh + m2, row = u.pm * 256 + ai * 128 + wr * 64 + m * 16 + fr; bf16_t* op = out + (size_t)row * DM + col0;
#pragma unroll
                    for (int bj = 0; bj < 2; ++bj) { const f32x4 v0 = xb[m2][bj][0] + gt[bj][0] * acc[ai][bj][m][0], v1 = xb[m2][bj][1] + gt[bj][1] * acc[ai][bj][m][1];
                        u32x4 w; w.x = pg8::cvt_pk_bf16(v0[0], v0[1]); w.y = pg8::cvt_pk_bf16(v0[2], v0[3]); w.z = pg8::cvt_pk_bf16(v1[0], v1[1]); w.w = pg8::cvt_pk_bf16(v1[2], v1[3]);
                        *(u32x4*)(op + bj * 128) = w; } }
                __builtin_amdgcn_sched_barrier(0); }
    }
};
struct EpiOut {
    static constexpr bool PERM = false;
    const bf16_t* base; const float* mod; float* out;
    __device__ __forceinline__ void operator()(const f32x4 (&acc)[2][2][4][2], const pg8::Unit& u, int wr, int wc, int fr, int fq) const {
        const int col0 = u.pn * 256 + wc * 32 + 4 * fq;
        const float* gp = mod + (size_t)(u.pm >> 4) * 6144 + 2 * DM + col0;
        f32x4 gt[2][2];
#pragma unroll
        for (int bj = 0; bj < 2; ++bj)
#pragma unroll
            for (int n = 0; n < 2; ++n) gt[bj][n] = *(const f32x4*)(gp + bj * 128 + n * 16);
#pragma unroll
        for (int ai = 0; ai < 2; ++ai) {
            u32x2 bw[4][2][2];
#pragma unroll
            for (int m = 0; m < 4; ++m) { const int row = u.pm * 256 + ai * 128 + wr * 64 + m * 16 + fr; const bf16_t* bp = base + (size_t)row * DM + col0;
#pragma unroll
                for (int bj = 0; bj < 2; ++bj)
#pragma unroll
                    for (int n = 0; n < 2; ++n) bw[m][bj][n] = *(const u32x2*)(bp + bj * 128 + n * 16); }
            __builtin_amdgcn_sched_barrier(0);
#pragma unroll
            for (int m = 0; m < 4; ++m) { const int row = u.pm * 256 + ai * 128 + wr * 64 + m * 16 + fr; float* op = out + (size_t)row * DM + col0;
#pragma unroll
                for (int bj = 0; bj < 2; ++bj)
#pragma unroll
                    for (int n = 0; n < 2; ++n) { const u32x2 w2 = bw[m][bj][n]; const f32x4 bs = (f32x4){bflo(w2.x), bfhi(w2.x), bflo(w2.y), bfhi(w2.y)};
                        *(f32x4*)(op + bj * 128 + n * 16) = bs + gt[bj][n] * acc[ai][bj][m][n]; } }
            __builtin_amdgcn_sched_barrier(0); }
    }
};
struct EpiP1 {
    static constexpr bool PERM = true;
    bf16_t* P1; const f32x2* ROT;
    __device__ __forceinline__ void operator()(const f32x4 (&acc)[2][2][4][2], const pg8::Unit& u, int wr, int wc, int fr, int fq) const {
        const int pn = u.pn, row0 = u.pm * 256 + wr * 64 + fr;
        const int col0 = pn * 256 + wc * 32 + 8 * fq;
        if (pn < 16) {
            const float ksc = pn >= 8 ? 0.0625f : 1.f;
            const int d0 = wc * 32 + 8 * fq;
#pragma unroll
            for (int ai = 0; ai < 2; ++ai)
#pragma unroll
                for (int m = 0; m < 4; ++m) { const int row = row0 + ai * 128 + m * 16;
                    const int pi = row < TP ? (row & 4095) : 4096 + (row & 3);
                    const f32x4* rp = (const f32x4*)(ROT + (size_t)pi * 128 + d0);
                    f32x4 o1[2], o2[2];
#pragma unroll
                    for (int n = 0; n < 2; ++n) { const f32x4 cs0 = rp[2 * n], cs1 = rp[2 * n + 1];
                        const f32x4 x1 = acc[ai][0][m][n], x2 = acc[ai][1][m][n];
                        const f32x4 c = (f32x4){cs0.x, cs0.z, cs1.x, cs1.z}, s = (f32x4){cs0.y, cs0.w, cs1.y, cs1.w};
                        o1[n] = (x1 * c - x2 * s) * ksc; o2[n] = (x2 * c + x1 * s) * ksc; }
                    bf16_t* rowp = P1 + (size_t)row * N3 + col0;
                    u32x4 w; w.x = pg8::cvt_pk_bf16(o1[0][0], o1[0][1]); w.y = pg8::cvt_pk_bf16(o1[0][2], o1[0][3]); w.z = pg8::cvt_pk_bf16(o1[1][0], o1[1][1]); w.w = pg8::cvt_pk_bf16(o1[1][2], o1[1][3]);
                    *(u32x4*)rowp = w;
                    w.x = pg8::cvt_pk_bf16(o2[0][0], o2[0][1]); w.y = pg8::cvt_pk_bf16(o2[0][2], o2[0][3]); w.z = pg8::cvt_pk_bf16(o2[1][0], o2[1][1]); w.w = pg8::cvt_pk_bf16(o2[1][2], o2[1][3]);
                    *(u32x4*)(rowp + 128) = w; }
            return;
        }
        const bool do_silu = pn >= 32;
#pragma unroll
        for (int ai = 0; ai < 2; ++ai)
#pragma unroll
            for (int m = 0; m < 4; ++m) { bf16_t* rowp = P1 + (size_t)(row0 + ai * 128 + m * 16) * N3 + col0;
#pragma unroll
                for (int bj = 0; bj < 2; ++bj) { f32x4 v0 = acc[ai][bj][m][0], v1 = acc[ai][bj][m][1];
                    if (do_silu) {
#pragma unroll
                        for (int j = 0; j < 4; ++j) { v0[j] = silu_f(v0[j]); v1[j] = silu_f(v1[j]); } }
                    u32x4 w; w.x = pg8::cvt_pk_bf16(v0[0], v0[1]); w.y = pg8::cvt_pk_bf16(v0[2], v0[3]); w.z = pg8::cvt_pk_bf16(v1[0], v1[1]); w.w = pg8::cvt_pk_bf16(v1[2], v1[3]);
                    *(u32x4*)(rowp + bj * 128) = w; } }
    }
};

template <bool OUT_BF16  >
__device__ __forceinline__ void mini_gemm_sample(const Frame& F, const bf16_t* A  , const bf16_t* Bt  , int K, const void* base1v, const float* mod, void* outv) {
    const int lane = F.lane, w = F.wave, g = lane >> 4, i15 = lane & 15, tid = F.tid;
    LAS float* part = (LAS float*)F.lds;
    for (int tile = blockIdx.x; tile < 256; tile += F.G) {
        const int r0 = (tile >> 5) * 64, c0 = (tile & 31) * 64;
        f32x4 acc[4][4];
#pragma unroll
        for (int m = 0; m < 4; ++m)
#pragma unroll
            for (int n = 0; n < 4; ++n) acc[m][n] = (f32x4){0.f, 0.f, 0.f, 0.f};
        const int kw = K >> 3, nks = kw >> 5;
        const bf16_t* ap = A + (size_t)(r0 + i15) * K + w * kw + 8 * g;
        const bf16_t* bp = Bt + (size_t)(c0 + i15) * K + w * kw + 8 * g;
#pragma unroll 1
        for (int ks = 0; ks < nks; ks += 4) {
            bf16x8 a[4][4], b[4][4];
#pragma unroll
            for (int u = 0; u < 4; ++u)
#pragma unroll
                for (int m = 0; m < 4; ++m) { a[u][m] = *(const bf16x8*)(ap + (size_t)(16 * m) * K + 32 * (ks + u)); b[u][m] = *(const bf16x8*)(bp + (size_t)(16 * m) * K + 32 * (ks + u)); }
            __builtin_amdgcn_sched_barrier(0);
#pragma unroll
            for (int u = 0; u < 4; ++u)
#pragma unroll
                for (int m = 0; m < 4; ++m)
#pragma unroll
                    for (int n = 0; n < 4; ++n) acc[m][n] = MFMA16(a[u][m], b[u][n], acc[m][n]);
            __builtin_amdgcn_sched_barrier(0);
        }
#pragma unroll
        for (int m = 0; m < 4; ++m)
#pragma unroll
            for (int n = 0; n < 4; ++n)
#pragma unroll
                for (int r = 0; r < 4; ++r) part[w * 4096 + (16 * m + 4 * g + r) * 64 + 16 * n + i15] = acc[m][n][r];
        __syncthreads();
        { const int row = tid >> 3, c8 = (tid & 7) * 8;
          f32x4 s0 = (f32x4){0.f, 0.f, 0.f, 0.f}, s1 = s0;
#pragma unroll
          for (int ww = 0; ww < 8; ++ww) { s0 += *(const LAS f32x4*)(part + ww * 4096 + row * 64 + c8); s1 += *(const LAS f32x4*)(part + ww * 4096 + row * 64 + c8 + 4); }
          const int rs = r0 + row, col = c0 + c8;
          const float* gp = mod + (size_t)(2 + (rs >> 2)) * 6144 + 2 * DM + col;
          if constexpr (OUT_BF16) { const float* bs = (const float*)base1v + (size_t)rs * DM + col; bf16_t* op = (bf16_t*)outv + (size_t)(TP + rs) * DM + col;
              const f32x4 v0 = *(const f32x4*)bs + *(const f32x4*)gp * s0, v1 = *(const f32x4*)(bs + 4) + *(const f32x4*)(gp + 4) * s1;
              u32x4 o; o.x = pk2_hw(v0.x, v0.y); o.y = pk2_hw(v0.z, v0.w); o.z = pk2_hw(v1.x, v1.y); o.w = pk2_hw(v1.z, v1.w); *(u32x4*)op = o; }
          else { const bf16_t* bs = (const bf16_t*)base1v + (size_t)rs * DM + col; float* op = (float*)outv + (size_t)(TP + rs) * DM + col;
              const u32x4 bw = *(const u32x4*)bs;
              *(f32x4*)op = (f32x4){bflo(bw.x), bfhi(bw.x), bflo(bw.y), bfhi(bw.y)} + *(const f32x4*)gp * s0;
              *(f32x4*)(op + 4) = (f32x4){bflo(bw.z), bfhi(bw.z), bflo(bw.w), bfhi(bw.w)} + *(const f32x4*)(gp + 4) * s1; } }
        __syncthreads();
    }
}

__device__ __forceinline__ int t5_bucket(int dist) {
    if (dist < 16) return dist;
    const float lr = __logf((float)dist * (1.f / 16.f)) * (1.f / 2.0794415416798357f);
    int large = 16 + (int)(lr * 16.f);
    return large < 31 ? large : 31;
}

__device__ __forceinline__ void swa_prompt_item(const Frame& F, const Args& A, int it) {
    const int b = it >> 6, blk = (it >> 1) & 31, kvh = it & 1;
    int tid = F.tid; asm volatile("" : "+v"(tid));
    const int lane = tid & 63, w = F.wave, g = lane >> 4, i15 = lane & 15, h = kvh * 8 + w;
    const bf16_t* P0 = (const bf16_t*)(A.ws + WS_P0);
    bf16_t* MIX = (bf16_t*)(A.ws + WS_MIX);
    LAS bf16_t* Ks = (LAS bf16_t*)F.lds;
    LAS bf16_t* Vs = Ks + 256 * 72;
    LAS bf16_t* Ps = Vs + 272 * 72;
    LAS float* bias = (LAS float*)(Ps + 8 * 16 * 168);
    const int row0 = b * SEQ + blk * 128;
    const float* qn_g = A.in[I_QNG]; const float* kn_g = A.in[I_KNG];
    { const int ch = tid & 7, rr0 = tid >> 3; const bool has_prev = blk > 0;
      u32x4 kv[4], vv4[4];
#pragma unroll
      for (int i = 0; i < 4; ++i) { const int s = rr0 + 64 * i;
          if (s >= 128 || has_prev) { const size_t grow = (size_t)(row0 - 128 + s) * N1;
              kv[i] = *(const u32x4*)(P0 + grow + C_KA + kvh * 64 + 8 * ch); vv4[i] = *(const u32x4*)(P0 + grow + C_VA + kvh * 64 + 8 * ch); }
          else { kv[i] = (u32x4){0u, 0u, 0u, 0u}; vv4[i] = kv[i]; } }
      float gk[8];
#pragma unroll
      for (int j = 0; j < 8; ++j) gk[j] = kn_g[8 * ch + j];
#pragma unroll
      for (int i = 0; i < 4; ++i) { const int s = rr0 + 64 * i; const unsigned ww[4] = {kv[i].x, kv[i].y, kv[i].z, kv[i].w}; float x[8]; float ss = 0.f;
#pragma unroll
          for (int j = 0; j < 4; ++j) { x[2 * j] = bflo(ww[j]); x[2 * j + 1] = bfhi(ww[j]); ss += x[2 * j] * x[2 * j] + x[2 * j + 1] * x[2 * j + 1]; }
          ss += __shfl_xor(ss, 1); ss += __shfl_xor(ss, 2); ss += __shfl_xor(ss, 4);
          const float r = rsqrtf(ss * (1.f / 64.f) + EPS);
#pragma unroll
          for (int j = 0; j < 8; ++j) x[j] = x[j] * r * gk[j];
          u32x4 o; o.x = pk2(x[0], x[1]); o.y = pk2(x[2], x[3]); o.z = pk2(x[4], x[5]); o.w = pk2(x[6], x[7]);
          *(LAS u32x4*)(Ks + s * 72 + 8 * ch) = o; *(LAS u32x4*)(Vs + s * 72 + 8 * ch) = vv4[i];
          if (blk == 31 && s >= 128) {
              float* kp = A.out + O_KP + ((size_t)(b * 128 + s - 128) * 2 + kvh) * 64 + 8 * ch;
              float* vp = A.out + O_VP + ((size_t)(b * 128 + s - 128) * 2 + kvh) * 64 + 8 * ch;
              *(f32x4*)kp = (f32x4){x[0], x[1], x[2], x[3]}; *(f32x4*)(kp + 4) = (f32x4){x[4], x[5], x[6], x[7]};
              *(f32x4*)vp = (f32x4){bflo(vv4[i].x), bfhi(vv4[i].x), bflo(vv4[i].y), bfhi(vv4[i].y)}; *(f32x4*)(vp + 4) = (f32x4){bflo(vv4[i].z), bfhi(vv4[i].z), bflo(vv4[i].w), bfhi(vv4[i].w)}; } }
      if (tid < 64) { *(LAS u32x4*)(Vs + (256 + (tid >> 2)) * 72 + 16 * (tid & 3)) = (u32x4){0u, 0u, 0u, 0u}; *(LAS u32x4*)(Vs + (256 + (tid >> 2)) * 72 + 16 * (tid & 3) + 8) = (u32x4){0u, 0u, 0u, 0u}; }
      for (int idx = tid; idx < 8 * 129; idx += NTHREADS) { const int hh = idx / 129, d = idx % 129; bias[hh * 132 + d] = A.in[I_RB][t5_bucket(d) * 16 + kvh * 8 + hh]; } }
    const float L2E = 1.4426950408889634f;
    const bf16_t* qp = P0 + (size_t)(row0 + i15) * N1 + C_QA + h * 64 + 8 * g;
    u32x4 qn0 = *(const u32x4*)qp, qn1 = *(const u32x4*)(qp + 32);
    float gq[2][8];
#pragma unroll
    for (int k2 = 0; k2 < 2; ++k2)
#pragma unroll
        for (int j = 0; j < 8; ++j) gq[k2][j] = qn_g[32 * k2 + 8 * g + j] * (0.125f * L2E);
    const float sink2 = A.in[I_SNK][h] * L2E;
    __syncthreads();
    const LAS float* bh_ = bias + w * 132;
    LAS bf16_t* Pw = Ps + w * 16 * 168;
    float bt[9][4];
#pragma unroll
    for (int j = 0; j < 9; ++j)
#pragma unroll
        for (int r = 0; r < 4; ++r) { const int dist = 128 - 16 * j + 4 * g + r - i15; const bool ok = dist >= 0 && dist <= 128; bt[j][r] = ok ? bh_[ok ? dist : 0] * L2E : -1e30f; }
#pragma unroll
    for (int r = 0; r < 4; ++r) Pw[(4 * g + r) * 168 + 144 + i15] = 0;
#pragma unroll 1
    for (int m = 0; m < 8; ++m) {
        u32x4 gv[2];
#pragma unroll
        for (int i = 0; i < 2; ++i) { const int idx = lane + 64 * i; gv[i] = *(const u32x4*)(P0 + (size_t)(row0 + 16 * m + (idx >> 3)) * N1 + C_GA + h * 64 + 8 * (idx & 7)); }
        const u32x4 qc0 = qn0, qc1 = qn1;
        { const int mn = m < 7 ? m + 1 : 7; qn0 = *(const u32x4*)(qp + (size_t)(16 * mn) * N1); qn1 = *(const u32x4*)(qp + (size_t)(16 * mn) * N1 + 32); }
        bf16x8 qf[2];
        { float x[2][8]; float ss = 0.f;
#pragma unroll
          for (int k2 = 0; k2 < 2; ++k2) { const u32x4 qq = k2 ? qc1 : qc0; const unsigned ww[4] = {qq.x, qq.y, qq.z, qq.w};
#pragma unroll
              for (int j = 0; j < 4; ++j) { x[k2][2 * j] = bflo(ww[j]); x[k2][2 * j + 1] = bfhi(ww[j]); ss += x[k2][2 * j] * x[k2][2 * j] + x[k2][2 * j + 1] * x[k2][2 * j + 1]; } }
          ss += __shfl_xor(ss, 16); ss += __shfl_xor(ss, 32);
          const float rq = rsqrtf(ss * (1.f / 64.f) + EPS);
#pragma unroll
          for (int k2 = 0; k2 < 2; ++k2) { u32x4 o; o.x = pk2_hw(x[k2][0] * rq * gq[k2][0], x[k2][1] * rq * gq[k2][1]); o.y = pk2_hw(x[k2][2] * rq * gq[k2][2], x[k2][3] * rq * gq[k2][3]);
              o.z = pk2_hw(x[k2][4] * rq * gq[k2][4], x[k2][5] * rq * gq[k2][5]); o.w = pk2_hw(x[k2][6] * rq * gq[k2][6], x[k2][7] * rq * gq[k2][7]); qf[k2] = __builtin_bit_cast(bf16x8, o); } }
        f32x4 sacc[9];
#pragma unroll
        for (int j = 0; j < 9; ++j) sacc[j] = (f32x4){0.f, 0.f, 0.f, 0.f};
#pragma unroll
        for (int ks = 0; ks < 2; ++ks)
#pragma unroll
            for (int j = 0; j < 9; ++j) sacc[j] = MFMA16(qf[ks], frag_nat(Ks, 72, 16 * (m + j), 32 * ks, lane), sacc[j]);
#pragma unroll
        for (int r = 0; r < 4; ++r) {
            float mx = -1e30f;
#pragma unroll
            for (int j = 0; j < 9; ++j) { const float v = (blk > 0 || m + j >= 8) ? sacc[j][r] + bt[j][r] : -1e30f;
                sacc[j][r] = v; mx = fmaxf(mx, v); }
            mx = fmaxf(red16_max(mx), sink2);
            float sum = 0.f;
#pragma unroll
            for (int j = 0; j < 9; ++j) { const float p = __builtin_amdgcn_exp2f(sacc[j][r] - mx); sacc[j][r] = p; sum += p; }
            sum = red16_sum(sum) + __builtin_amdgcn_exp2f(sink2 - mx);
            const float inv = __builtin_amdgcn_rcpf(sum);
            LAS bf16_t* pr = Pw + (4 * g + r) * 168 + i15;
#pragma unroll
            for (int j = 0; j < 8; j += 2) { const unsigned pk = pk2_hw(sacc[j][r] * inv, sacc[j + 1][r] * inv); pr[16 * j] = (bf16_t)pk; pr[16 * j + 16] = (bf16_t)(pk >> 16); }
            pr[128] = (bf16_t)f2bf_hw(sacc[8][r] * inv);
        }
        f32x4 oacc[4];
#pragma unroll
        for (int e = 0; e < 4; ++e) oacc[e] = (f32x4){0.f, 0.f, 0.f, 0.f};
#pragma unroll
        for (int ks = 0; ks < 5; ++ks) { const bf16x8 a = frag_nat(Pw, 168, 0, 32 * ks, lane);
#pragma unroll
            for (int e = 0; e < 4; ++e) oacc[e] = MFMA16(a, frag_tr(Vs, 72, 16 * e, 16 * m + 32 * ks, lane), oacc[e]); }
#pragma unroll
        for (int r = 0; r < 4; ++r) { LAS bf16_t* pr = Pw + (4 * g + r) * 168 + i15;
#pragma unroll
            for (int e = 0; e < 4; e += 2) { const unsigned pk = pk2_hw(oacc[e][r], oacc[e + 1][r]); pr[16 * e] = (bf16_t)pk; pr[16 * e + 16] = (bf16_t)(pk >> 16); } }
#pragma unroll
        for (int i = 0; i < 2; ++i) { const int idx = lane + 64 * i, tr_ = idx >> 3, c8 = idx & 7; const size_t t = (size_t)(row0 + 16 * m + tr_);
            const u32x4 ov = *(const LAS u32x4*)(Pw + tr_ * 168 + 8 * c8);
            const u32x4 gvv = gv[i];
            u32x4 o;
            o.x = pk2_hw(bflo(ov.x) * bflo(gvv.x), bfhi(ov.x) * bfhi(gvv.x)); o.y = pk2_hw(bflo(ov.y) * bflo(gvv.y), bfhi(ov.y) * bfhi(gvv.y));
            o.z = pk2_hw(bflo(ov.z) * bflo(gvv.z), bfhi(ov.z) * bfhi(gvv.z)); o.w = pk2_hw(bflo(ov.w) * bflo(gvv.w), bfhi(ov.w) * bfhi(gvv.w));
            *(u32x4*)(MIX + t * DM + h * 64 + 8 * c8) = o; }
    }
}

__device__ __forceinline__ void swa_sample_item(const Frame& F, const Args& A, int it) {
    const int bd = it >> 1, kvh = it & 1, tid = F.tid, lane = F.lane, w = F.wave, g = lane >> 4, i15 = lane & 15;
    const bf16_t* P0 = (const bf16_t*)(A.ws + WS_P0);
    bf16_t* MIX = (bf16_t*)(A.ws + WS_MIX);
    LAS bf16_t* Kb = (LAS bf16_t*)F.lds;
    LAS bf16_t* Vb = Kb + 144 * 72;
    LAS bf16_t* Qb = Vb + 160 * 72;
    LAS bf16_t* Pb = Qb + 32 * 72;
    LAS float* Ps = (LAS float*)(Pb + 32 * 168);
    LAS float* bias = Ps + 32 * 148;
    const size_t rowb = (size_t)TP + bd * 4;
    const float* ck = A.in[I_CK]; const float* cv = A.in[I_CV];
    float* oks = A.out + O_KS; float* ovs = A.out + O_VS;
    const int mt = w & 1, ntv = w >> 1;
    f32x4 kq[4], vq[4];
#pragma unroll
    for (int i = 0; i < 4; ++i) { const int idx = tid + NTHREADS * i, j = idx >> 4, d4 = (idx & 15) * 4;
        const size_t gi = ((size_t)(bd * 128 + j) * 2 + kvh) * 64 + d4; kq[i] = *(const f32x4*)(ck + gi); vq[i] = *(const f32x4*)(cv + gi); }
    bf16_t xqr[4], gar[4];
#pragma unroll
    for (int rr = 0; rr < 4; ++rr) { const int r = 4 * w + rr; xqr[rr] = P0[(rowb + (r >> 3)) * N1 + C_QA + (kvh * 8 + (r & 7)) * 64 + lane]; }
    const float gqn = A.in[I_QNG][lane], gkn = A.in[I_KNG][lane];
    const bf16_t xkr = P0[(rowb + (w & 3)) * N1 + C_KA + kvh * 64 + lane], xvr = P0[(rowb + (w & 3)) * N1 + C_VA + kvh * 64 + lane];
    float sk[4];
#pragma unroll
    for (int rr = 0; rr < 4; ++rr) sk[rr] = A.in[I_SNK][kvh * 8 + ((4 * w + rr) & 7)];
#pragma unroll
    for (int q = 0; q < 4; ++q) { const int r = 16 * mt + 4 * g + q; gar[q] = P0[(rowb + (r >> 3)) * N1 + C_GA + (kvh * 8 + (r & 7)) * 64 + 16 * ntv + i15]; }
    float bv[3];
#pragma unroll
    for (int i = 0; i < 3; ++i) { const int idx0 = tid + NTHREADS * i, idx = idx0 < 8 * 129 ? idx0 : 0, gq = idx / 129, dist = idx % 129; bv[i] = A.in[I_RB][t5_bucket(dist) * 16 + kvh * 8 + gq]; }
    __builtin_amdgcn_sched_barrier(0);
#pragma unroll
    for (int i = 0; i < 4; ++i) { const int idx = tid + NTHREADS * i, j = idx >> 4, d4 = (idx & 15) * 4;
        u32x2 kb, vb; kb.x = pk2_hw(kq[i].x, kq[i].y); kb.y = pk2_hw(kq[i].z, kq[i].w); vb.x = pk2_hw(vq[i].x, vq[i].y); vb.y = pk2_hw(vq[i].z, vq[i].w);
        *(LAS u32x2*)(Kb + j * 72 + d4) = kb; *(LAS u32x2*)(Vb + j * 72 + d4) = vb;
        if (j >= 4) { const size_t go = ((size_t)(bd * 128 + j - 4) * 2 + kvh) * 64 + d4; *(f32x4*)(oks + go) = kq[i]; *(f32x4*)(ovs + go) = vq[i]; } }
#pragma unroll
    for (int rr = 0; rr < 4; ++rr) { const int r = 4 * w + rr; const float x = bf2f(xqr[rr]); const float ss = wave_sum(x * x);
        Qb[r * 72 + lane] = (bf16_t)f2bf_hw(x * rsqrtf(ss * (1.f / 64.f) + EPS) * gqn * 0.125f); }
    { const float x = bf2f(xkr); const float ss = wave_sum(x * x);
      const float kn = x * rsqrtf(ss * (1.f / 64.f) + EPS) * gkn, vn = bf2f(xvr);
      if (w < 4) { Kb[(128 + w) * 72 + lane] = (bf16_t)f2bf_hw(kn); Vb[(128 + w) * 72 + lane] = (bf16_t)f2bf_hw(vn);
          const size_t go = ((size_t)(bd * 128 + 124 + w) * 2 + kvh) * 64 + lane; oks[go] = kn; ovs[go] = vn; } }
    if (tid < 108) *(LAS u32x4*)(Kb + 132 * 72 + 8 * tid) = (u32x4){0u, 0u, 0u, 0u};
    else if (tid >= 128 && tid < 128 + 252) *(LAS u32x4*)(Vb + 132 * 72 + 8 * (tid - 128)) = (u32x4){0u, 0u, 0u, 0u};
#pragma unroll
    for (int i = 0; i < 3; ++i) { const int idx = tid + NTHREADS * i; if (idx < 8 * 129) bias[(idx / 129) * 132 + idx % 129] = bv[i]; }
    __syncthreads();
    for (int nt = w; nt < 9; nt += 8) {
        const bf16x8 kb0 = frag_nat(Kb, 72, 16 * nt, 0, lane), kb1 = frag_nat(Kb, 72, 16 * nt, 32, lane);
#pragma unroll
        for (int m = 0; m < 2; ++m) { f32x4 acc = (f32x4){0.f, 0.f, 0.f, 0.f};
            acc = MFMA16(frag_nat(Qb, 72, 16 * m, 0, lane), kb0, acc); acc = MFMA16(frag_nat(Qb, 72, 16 * m, 32, lane), kb1, acc);
#pragma unroll
            for (int q = 0; q < 4; ++q) { const int r = 16 * m + 4 * g + q, l = r >> 3, gq = r & 7, s = 16 * nt + i15, dist = 128 + l - s;
                const bool ok = dist >= 0 && dist <= 128;
                Ps[r * 148 + s] = ok ? acc[q] + bias[gq * 132 + (ok ? dist : 0)] : -1e30f; } } }
    __syncthreads();
#pragma unroll
    for (int rr = 0; rr < 4; ++rr) { const int r = 4 * w + rr; const float sink = sk[rr];
        const float v0 = Ps[r * 148 + lane], v1 = Ps[r * 148 + 64 + lane], v2 = lane < 4 ? Ps[r * 148 + 128 + lane] : -1e30f;
        float mx = fmaxf(fmaxf(v0, v1), v2);
#pragma unroll
        for (int o = 1; o < 64; o <<= 1) mx = fmaxf(mx, __shfl_xor(mx, o));
        mx = fmaxf(mx, sink);
        const float p0 = __expf(v0 - mx), p1 = __expf(v1 - mx), p2 = lane < 4 ? __expf(v2 - mx) : 0.f;
        const float inv = 1.f / (wave_sum(p0 + p1 + p2) + __expf(sink - mx));
        Pb[r * 168 + lane] = (bf16_t)f2bf_hw(p0 * inv); Pb[r * 168 + 64 + lane] = (bf16_t)f2bf_hw(p1 * inv); if (lane < 40) Pb[r * 168 + 128 + lane] = (bf16_t)f2bf_hw(p2 * inv); }
    __syncthreads();
    { f32x4 o = (f32x4){0.f, 0.f, 0.f, 0.f};
#pragma unroll
      for (int ks = 0; ks < 5; ++ks) o = MFMA16(frag_nat(Pb, 168, 16 * mt, 32 * ks, lane), frag_tr(Vb, 72, 16 * ntv, 32 * ks, lane), o);
#pragma unroll
      for (int q = 0; q < 4; ++q) { const int r = 16 * mt + 4 * g + q;
          MIX[(rowb + (r >> 3)) * DM + (kvh * 8 + (r & 7)) * 64 + 16 * ntv + i15] = (bf16_t)f2bf_hw(o[q] * bf2f(gar[q])); } }
}

__device__ __forceinline__ void gla_sample_item(const Frame& F, const Args& A, int it) {
    const int bd = it >> 2, h = it & 3, tid = F.tid, lane = F.lane, w = F.wave;
    const bf16_t* P0 = (const bf16_t*)(A.ws + WS_P0);
    const float* LR = (const float*)(A.ws + WS_LR);
    bf16_t* MIX = (bf16_t*)(A.ws + WS_MIX);
    LAS float* qt = (LAS float*)F.lds;
    LAS float* kt = qt + 512;
    LAS float* kd = kt + 512;
    LAS float* dec = kd + 512;
    LAS float* vv = dec + 128;
    LAS float* Am = vv + 1024;
    LAS float* OACC = Am + 16;
    LAS float* red = OACC + 8 * 4 * 256;
    const size_t rowb = (size_t)TP + bd * 4;
    f32x4 s0[16];
    { const float* S0 = A.in[I_SG] + ((size_t)(bd * 4 + h) * 128 + (tid >> 6) * 16) * 256 + 4 * (tid & 63);
#pragma unroll
      for (int j = 0; j < 16; ++j) s0[j] = __builtin_nontemporal_load((const f32x4*)(S0 + (size_t)j * 256)); }
    if (tid < 128) { const int d = tid; float bc[4]; float run = 0.f;
        const float* wl = A.in[I_WLR] + h * 128 + d;
        float wv[16]; f32x4 lrv[16]; float qv[4], kv[4];
#pragma unroll
        for (int j = 0; j < 16; ++j) { wv[j] = wl[j * 512]; lrv[j] = *(const f32x4*)(LR + rowb * 16 + 4 * j); }
#pragma unroll
        for (int t = 0; t < 4; ++t) { qv[t] = bf2f(P0[(rowb + t) * N1 + C_QB + h * 128 + d]); kv[t] = bf2f(P0[(rowb + t) * N1 + C_KB + h * 128 + d]); }
        const float bl = A.in[I_BLR][h * 128 + d];
        __builtin_amdgcn_sched_barrier(0);
#pragma unroll
        for (int t = 0; t < 4; ++t) { float z = bl;
#pragma unroll
            for (int j4 = 0; j4 < 4; ++j4) { const f32x4 l = lrv[4 * t + j4]; z += l.x * wv[4 * j4] + l.y * wv[4 * j4 + 1] + l.z * wv[4 * j4 + 2] + l.w * wv[4 * j4 + 3]; }
            run += logsig_f(z) * (1.f / 16.f); bc[t] = run; }
#pragma unroll
        for (int t = 0; t < 4; ++t) { const float q = qv[t], k = kv[t];
            qt[t * 128 + d] = q * __expf(bc[t]); kt[t * 128 + d] = k * __expf(-bc[t]); kd[t * 128 + d] = k * __expf(bc[3] - bc[t]); }
        dec[d] = __expf(bc[3]); }
    { const int e = tid & 255, t0 = (tid >> 8) * 2;
      vv[t0 * 256 + e] = bf2f(P0[(rowb + t0) * N1 + C_VB + h * 256 + e]); vv[(t0 + 1) * 256 + e] = bf2f(P0[(rowb + t0 + 1) * N1 + C_VB + h * 256 + e]); }
    __syncthreads();
    { const int pair = tid >> 5, sub = tid & 31, t = pair >> 2, s = pair & 3; float p = 0.f;
#pragma unroll
      for (int i = 0; i < 4; ++i) p += qt[t * 128 + sub + 32 * i] * kt[s * 128 + sub + 32 * i];
      p += __shfl_xor(p, 1); p += __shfl_xor(p, 2); p += __shfl_xor(p, 4); p += __shfl_xor(p, 8); p += __shfl_xor(p, 16);
      if (sub == 0) Am[pair] = (s <= t) ? p : 0.f; }
    { const int e4 = tid & 63, dg = tid >> 6;
      const float* S0 = A.in[I_SG] + ((size_t)(bd * 4 + h) * 128 + dg * 16) * 256 + 4 * e4;
      float* SN = A.out + O_GS + ((size_t)(bd * 4 + h) * 128 + dg * 16) * 256 + 4 * e4;
      f32x4 vr[4];
#pragma unroll
      for (int t = 0; t < 4; ++t) vr[t] = *(const LAS f32x4*)(vv + t * 256 + 4 * e4);
      f32x4 oa[4];
#pragma unroll
      for (int t = 0; t < 4; ++t) oa[t] = (f32x4){0.f, 0.f, 0.f, 0.f};
      {
#pragma unroll
        for (int j = 0; j < 16; ++j) { const int d = dg * 16 + j;
            f32x4 sn = s0[j] * dec[d];
#pragma unroll
            for (int t = 0; t < 4; ++t) { sn += vr[t] * kd[t * 128 + d]; oa[t] += s0[j] * qt[t * 128 + d]; }
            __builtin_nontemporal_store(sn, (f32x4*)(SN + (size_t)j * 256)); } }
#pragma unroll
      for (int t = 0; t < 4; ++t) *(LAS f32x4*)(OACC + (dg * 4 + t) * 256 + 4 * e4) = oa[t]; }
    __syncthreads();
    { const int e = tid & 255, t0 = (tid >> 8) * 2; float o[2];
#pragma unroll
      for (int tt = 0; tt < 2; ++tt) { const int t = t0 + tt; float s = 0.f;
#pragma unroll
          for (int dgi = 0; dgi < 8; ++dgi) s += OACC[(dgi * 4 + t) * 256 + e];
#pragma unroll
          for (int s2 = 0; s2 < 4; ++s2) s += Am[t * 4 + s2] * vv[s2 * 256 + e];
          o[tt] = s; }
      const float s0 = wave_sum(o[0] * o[0]), s1 = wave_sum(o[1] * o[1]);
      if (lane == 0) { red[w * 2] = s0; red[w * 2 + 1] = s1; }
      __syncthreads();
      const int wb = (tid >> 8) * 4;
      const float q0 = red[wb * 2] + red[(wb + 1) * 2] + red[(wb + 2) * 2] + red[(wb + 3) * 2];
      const float q1 = red[wb * 2 + 1] + red[(wb + 1) * 2 + 1] + red[(wb + 2) * 2 + 1] + red[(wb + 3) * 2 + 1];
      const float gg = A.in[I_GLG][e];
      const float r0 = rsqrtf(q0 * (1.f / 256.f) + EPS), r1 = rsqrtf(q1 * (1.f / 256.f) + EPS);
      const float g0 = bf2f(P0[(rowb + t0) * N1 + C_GB + h * 256 + e]), g1 = bf2f(P0[(rowb + t0 + 1) * N1 + C_GB + h * 256 + e]);
      MIX[(rowb + t0) * DM + 1024 + h * 256 + e] = (bf16_t)f2bf(o[0] * r0 * gg * g0);
      MIX[(rowb + t0 + 1) * DM + 1024 + h * 256 + e] = (bf16_t)f2bf(o[1] * r1 * gg * g1); }
}

__device__ __forceinline__ void gla_state_item(const Frame& F, const Args& A, int it) {
    const int bh = it >> 3, db = it & 7, b = bh >> 2, h = bh & 3;
    const int tid = F.tid, lane = F.lane, w = F.wave, g = lane >> 4, i15 = lane & 15;
    const bf16_t* P0 = (const bf16_t*)(A.ws + WS_P0);
    const float* LR = (const float*)(A.ws + WS_LR);
    bf16_t* SPG = (bf16_t*)(A.ws + WS_SPG);
    LAS float* WL = (LAS float*)F.lds;
    LAS float* BL = WL + 256;
    LAS float* DEC = BL + 16;
    LAS bf16_t* KD = (LAS bf16_t*)(DEC + 32);
    LAS bf16_t* STW = KD + 2 * 64 * 24;
    LAS bf16_t* VS = STW + 4 * 64 * 16;
    if (tid < 256) WL[tid] = A.in[I_WLR][(tid >> 4) * 512 + h * 128 + db * 16 + (tid & 15)];
    if (tid < 16) BL[tid] = A.in[I_BLR][h * 128 + db * 16 + tid];
    __syncthreads();
    const size_t rowb = (size_t)b * SEQ;
    const bool prep = w < 4;
    const float* lp = LR + (rowb + lane) * 16;
    const bf16_t* kp = P0 + (rowb + lane) * N1 + C_KB + h * 128 + db * 16 + 4 * (w & 3);
    const bf16_t* vp = P0 + (rowb + ((tid & 255) >> 5)) * N1 + C_VB + h * 256 + 8 * (tid & 31);
    f32x4 lrA[4], lrB[4]; u32x2 kA = (u32x2){0u, 0u}, kB = kA; u32x4 vA[8], vB[8];
#define GSP_LOAD(LRR, KK, VV, cc) do { const size_t _o = (size_t)(cc) * 64; \
        _Pragma("unroll") for (int _j = 0; _j < 4; ++_j) LRR[_j] = *(const f32x4*)(lp + _o * 16 + 4 * _j); \
        KK = *(const u32x2*)(kp + _o * N1); \
        _Pragma("unroll") for (int _i = 0; _i < 8; ++_i) VV[_i] = *(const u32x4*)(vp + (_o + 8 * _i) * N1); } while (0)
#define GSP_PREP(LRR, KK, VV, nb) do { \
        f32x4 _zz = blr; \
        _Pragma("unroll") for (int _j = 0; _j < 4; ++_j) { _zz += wlr[4 * _j] * LRR[_j].x; _zz += wlr[4 * _j + 1] * LRR[_j].y; _zz += wlr[4 * _j + 2] * LRR[_j].z; _zz += wlr[4 * _j + 3] * LRR[_j].w; } \
        const float _z[4] = {_zz.x, _zz.y, _zz.z, _zz.w}; \
        float _bc[4], _tot[4]; \
        _Pragma("unroll") for (int _q = 0; _q < 4; ++_q) { const float _v = wave_incl_scan(logsig_f(_z[_q]) * (1.f / 16.f)); \
            _bc[_q] = _v; _tot[_q] = __builtin_bit_cast(float, __builtin_amdgcn_readlane(__builtin_bit_cast(int, _v), 63)); } \
        const float _k0 = bflo(KK.x), _k1 = bfhi(KK.x), _k2 = bflo(KK.y), _k3 = bfhi(KK.y); \
        u32x2 _o2; _o2.x = pg8::cvt_pk_bf16(_k0 * __expf(_tot[0] - _bc[0]), _k1 * __expf(_tot[1] - _bc[1])); _o2.y = pg8::cvt_pk_bf16(_k2 * __expf(_tot[2] - _bc[2]), _k3 * __expf(_tot[3] - _bc[3])); \
        *(LAS u32x2*)(KD + (nb) * (64 * 24) + lane * 24 + 4 * (w & 3)) = _o2; \
        if (lane == 0) { _Pragma("unroll") for (int _q = 0; _q < 4; ++_q) DEC[(nb) * 16 + 4 * (w & 3) + _q] = __expf(_tot[_q]); } \
        _Pragma("unroll") for (int _i = 0; _i < 8; ++_i) *(LAS u32x4*)(VS + (nb) * (64 * 264) + (((tid & 255) >> 5) + 8 * _i) * 264 + 8 * (tid & 31)) = VV[_i]; } while (0)
    f32x4 wlr[16], blr;
#pragma unroll
    for (int j = 0; j < 16; ++j) wlr[j] = *(const LAS f32x4*)(WL + j * 16 + 4 * (w & 3));
    blr = *(const LAS f32x4*)(BL + 4 * (w & 3));
    const int mw = w & 3;
    f32x4 S[4];
#pragma unroll
    for (int n = 0; n < 4; ++n) S[n] = (f32x4){0.f, 0.f, 0.f, 0.f};
    LAS bf16_t* stw = STW + mw * (64 * 16);
#define GSC_STEP(cc) do { const int _cb = (cc) & 1; \
        _Pragma("unroll") for (int _n = 0; _n < 4; ++_n) { const unsigned _p0 = pg8::cvt_pk_bf16(S[_n][0], S[_n][1]), _p1 = pg8::cvt_pk_bf16(S[_n][2], S[_n][3]); \
            stw[(16 * _n + 4 * g + 0) * 16 + i15] = (bf16_t)_p0; stw[(16 * _n + 4 * g + 1) * 16 + i15] = (bf16_t)(_p0 >> 16); \
            stw[(16 * _n + 4 * g + 2) * 16 + i15] = (bf16_t)_p1; stw[(16 * _n + 4 * g + 3) * 16 + i15] = (bf16_t)(_p1 >> 16); } \
        { bf16_t* _dst = SPG + ((size_t)(bh * 64 + (cc)) * 256 + 64 * mw + lane) * 128 + db * 16; \
          *(u32x4*)_dst = *(const LAS u32x4*)(stw + lane * 16); *(u32x4*)(_dst + 8) = *(const LAS u32x4*)(stw + lane * 16 + 8); } \
        f32x4 _nw[4]; \
        _Pragma("unroll") for (int _n = 0; _n < 4; ++_n) _nw[_n] = (f32x4){0.f, 0.f, 0.f, 0.f}; \
        _Pragma("unroll") for (int _ks = 0; _ks < 2; ++_ks) { const bf16x8 _bb = frag_tr(KD + _cb * (64 * 24), 24, 0, 32 * _ks, lane); \
            _Pragma("unroll") for (int _n = 0; _n < 4; ++_n) _nw[_n] = MFMA16(frag_tr(VS + _cb * (64 * 264), 264, 64 * mw + 16 * _n, 32 * _ks, lane), _bb, _nw[_n]); } \
        const float _dc = DEC[_cb * 16 + i15]; \
        _Pragma("unroll") for (int _n = 0; _n < 4; ++_n) S[_n] = S[_n] * _dc + _nw[_n]; } while (0)
    if (prep) { GSP_LOAD(lrA, kA, vA, 0); GSP_LOAD(lrB, kB, vB, 1); GSP_PREP(lrA, kA, vA, 0); GSP_LOAD(lrA, kA, vA, 2); }
    __syncthreads();
#pragma unroll 1
    for (int c = 0; c < 64; c += 2) {
        if (prep) { GSP_PREP(lrB, kB, vB, 1); if (c + 3 < 64) GSP_LOAD(lrB, kB, vB, c + 3); }
        else GSC_STEP(c);
        __syncthreads();
        if (prep) { if (c + 2 < 64) { GSP_PREP(lrA, kA, vA, 0); if (c + 4 < 64) GSP_LOAD(lrA, kA, vA, c + 4); } }
        else GSC_STEP(c + 1);
        __syncthreads();
    }
#undef GSP_LOAD
#undef GSP_PREP
#undef GSC_STEP
    if (!prep) { int ln = lane; asm volatile("" : "+v"(ln));
        float* gp = A.out + O_GP + ((size_t)bh * 128 + db * 16 + (ln & 15)) * 256 + 64 * mw + 4 * (ln >> 4);
#pragma unroll
        for (int n = 0; n < 4; ++n) *(f32x4*)(gp + 16 * n) = S[n]; }
}

__device__ __forceinline__ void gla_out_item(const Frame& F, const Args& A, int it) {
    const int bh = it >> 6, c = it & 63, b = bh >> 2, h = bh & 3;
    const int tid = F.tid, lane = F.lane, w = F.wave, g = lane >> 4, i15 = lane & 15;
    const bf16_t* P0 = (const bf16_t*)(A.ws + WS_P0);
    const float* LR = (const float*)(A.ws + WS_LR);
    const bf16_t* SPG = (const bf16_t*)(A.ws + WS_SPG);
    bf16_t* MIX = (bf16_t*)(A.ws + WS_MIX);
    LAS float* WL = (LAS float*)F.lds;
    LAS float* BL = WL + 2048;
    LAS float* LRs = BL + 128;
    LAS float* LA = LRs + 1024;
    LAS float* SEG = LA + 64 * 129;
    LAS bf16_t* QT = (LAS bf16_t*)(SEG + 512);
    LAS bf16_t* KT = QT + 64 * 136;
    LAS bf16_t* VS = KT + 64 * 136;
    LAS bf16_t* AM = VS + 64 * 264;
    LAS float* RS = (LAS float*)(AM + 64 * 72);
    const size_t row0 = (size_t)b * SEQ + c * 64;
    const int t8 = tid >> 3, c8 = tid & 7;
    const bf16_t* qsrc = P0 + (row0 + t8) * N1 + C_QB + h * 128 + 16 * c8;
    const bf16_t* ksrc = P0 + (row0 + t8) * N1 + C_KB + h * 128 + 16 * c8;
    const u32x4 q0 = *(const u32x4*)qsrc, q1 = *(const u32x4*)(qsrc + 8), k0 = *(const u32x4*)ksrc, k1 = *(const u32x4*)(ksrc + 8);
    { const bf16_t* vsrc = P0 + (row0 + t8) * N1 + C_VB + h * 256 + 32 * c8;
#pragma unroll
      for (int j = 0; j < 4; ++j) *(LAS u32x4*)(VS + t8 * 264 + 32 * c8 + 8 * j) = *(const u32x4*)(vsrc + 8 * j); }
    { float wv[4];
#pragma unroll
      for (int i = 0; i < 4; ++i) { const int idx = tid + NTHREADS * i; wv[i] = A.in[I_WLR][(idx >> 7) * 512 + h * 128 + (idx & 127)]; }
      const float blv = A.in[I_BLR][h * 128 + (tid & 127)];
      const f32x4 lv = *(const f32x4*)(LR + row0 * 16 + 4 * (tid & 255));
#pragma unroll
      for (int i = 0; i < 4; ++i) WL[tid + NTHREADS * i] = wv[i];
      if (tid < 128) BL[tid] = blv;
      if (tid < 256) *(LAS f32x4*)(LRs + 4 * tid) = lv; }
    __syncthreads();
    { float lr[16];
#pragma unroll
      for (int j = 0; j < 16; ++j) lr[j] = LRs[t8 * 16 + j];
#pragma unroll
      for (int q = 0; q < 16; ++q) { const int d = 16 * c8 + q; float z = BL[d];
#pragma unroll
          for (int j = 0; j < 16; ++j) z += lr[j] * WL[j * 128 + d];
          LA[t8 * 129 + d] = logsig_f(z) * (1.f / 16.f); } }
    __syncthreads();
    { const int d = tid & 127, seg = tid >> 7; float p[16]; float run = 0.f;
#pragma unroll
      for (int q = 0; q < 16; ++q) { run += LA[(16 * seg + q) * 129 + d]; p[q] = run; }
      SEG[seg * 128 + d] = run;
      __syncthreads();
      float off = 0.f;
#pragma unroll
      for (int s2 = 0; s2 < 3; ++s2) off += (s2 < seg) ? SEG[s2 * 128 + d] : 0.f;
#pragma unroll
      for (int q = 0; q < 16; ++q) LA[(16 * seg + q) * 129 + d] = off + p[q]; }
    __syncthreads();
    { const unsigned qw[8] = {q0.x, q0.y, q0.z, q0.w, q1.x, q1.y, q1.z, q1.w}, kw[8] = {k0.x, k0.y, k0.z, k0.w, k1.x, k1.y, k1.z, k1.w};
      unsigned qo[8], ko[8];
#pragma unroll
      for (int j = 0; j < 8; ++j) { const float b0 = LA[t8 * 129 + 16 * c8 + 2 * j], b1 = LA[t8 * 129 + 16 * c8 + 2 * j + 1];
          qo[j] = pk2_hw(bflo(qw[j]) * __expf(b0), bfhi(qw[j]) * __expf(b1)); ko[j] = pk2_hw(bflo(kw[j]) * __expf(-b0), bfhi(kw[j]) * __expf(-b1)); }
      *(LAS u32x4*)(QT + t8 * 136 + 16 * c8) = (u32x4){qo[0], qo[1], qo[2], qo[3]}; *(LAS u32x4*)(QT + t8 * 136 + 16 * c8 + 8) = (u32x4){qo[4], qo[5], qo[6], qo[7]};
      *(LAS u32x4*)(KT + t8 * 136 + 16 * c8) = (u32x4){ko[0], ko[1], ko[2], ko[3]}; *(LAS u32x4*)(KT + t8 * 136 + 16 * c8 + 8) = (u32x4){ko[4], ko[5], ko[6], ko[7]}; }
    __syncthreads();
    { const int tt = w >> 1, st0 = 2 * (w & 1);
      f32x4 a0 = (f32x4){0.f, 0.f, 0.f, 0.f}, a1 = a0;
#pragma unroll
      for (int ks = 0; ks < 4; ++ks) { const bf16x8 a = frag_nat(QT, 136, 16 * tt, 32 * ks, lane);
          a0 = MFMA16(a, frag_nat(KT, 136, 16 * st0, 32 * ks, lane), a0); a1 = MFMA16(a, frag_nat(KT, 136, 16 * st0 + 16, 32 * ks, lane), a1); }
#pragma unroll
      for (int r = 0; r < 4; ++r) { const int t = 16 * tt + 4 * g + r, s0 = 16 * st0 + i15, s1 = s0 + 16;
          AM[t * 72 + s0] = (bf16_t)f2bf_hw(s0 <= t ? a0[r] : 0.f); AM[t * 72 + s1] = (bf16_t)f2bf_hw(s1 <= t ? a1[r] : 0.f); } }
    __syncthreads();
    f32x4 acc[4][2];
#pragma unroll
    for (int m = 0; m < 4; ++m) { acc[m][0] = (f32x4){0.f, 0.f, 0.f, 0.f}; acc[m][1] = acc[m][0]; }
#pragma unroll
    for (int ks = 0; ks < 2; ++ks) { const bf16x8 b0 = frag_tr(VS, 264, 32 * w, 32 * ks, lane), b1 = frag_tr(VS, 264, 32 * w + 16, 32 * ks, lane);
#pragma unroll
        for (int m = 0; m < 4; ++m) { const bf16x8 a = frag_nat(AM, 72, 16 * m, 32 * ks, lane); acc[m][0] = MFMA16(a, b0, acc[m][0]); acc[m][1] = MFMA16(a, b1, acc[m][1]); } }
    { const bf16_t* sp = SPG + ((size_t)(bh * 64 + c) * 256 + 32 * w + i15) * 128 + 8 * g;
      bf16x8 sb[4][2];
#pragma unroll
      for (int ks = 0; ks < 4; ++ks) { sb[ks][0] = *(const bf16x8*)(sp + 32 * ks); sb[ks][1] = *(const bf16x8*)(sp + 16 * 128 + 32 * ks); }
      __builtin_amdgcn_sched_barrier(0);
#pragma unroll
      for (int ks = 0; ks < 4; ++ks) {
#pragma unroll
          for (int m = 0; m < 4; ++m) { const bf16x8 a = frag_nat(QT, 136, 16 * m, 32 * ks, lane); acc[m][0] = MFMA16(a, sb[ks][0], acc[m][0]); acc[m][1] = MFMA16(a, sb[ks][1], acc[m][1]); } } }
#pragma unroll
    for (int m = 0; m < 4; ++m)
#pragma unroll
        for (int r = 0; r < 4; ++r) { float ss = acc[m][0][r] * acc[m][0][r] + acc[m][1][r] * acc[m][1][r]; ss = red16_sum(ss); if (i15 == 0) RS[w * 64 + 16 * m + 4 * g + r] = ss; }
    __syncthreads();
    { const float g0 = A.in[I_GLG][32 * w + i15], g1 = A.in[I_GLG][32 * w + 16 + i15];
#pragma unroll
      for (int m = 0; m < 4; ++m)
#pragma unroll
          for (int r = 0; r < 4; ++r) { const int t = 16 * m + 4 * g + r; float q = 0.f;
#pragma unroll
              for (int ww = 0; ww < 8; ++ww) q += RS[ww * 64 + t];
              const float rr = rsqrtf(q * (1.f / 256.f) + EPS);
              VS[t * 264 + 32 * w + i15] = (bf16_t)f2bf_hw(acc[m][0][r] * rr * g0);
              VS[t * 264 + 32 * w + 16 + i15] = (bf16_t)f2bf_hw(acc[m][1][r] * rr * g1); } }
    u32x4 gva[4];
#pragma unroll
    for (int i = 0; i < 4; ++i) { const int idx = tid + NTHREADS * i, t = idx >> 5, ch = idx & 31; gva[i] = *(const u32x4*)(P0 + (row0 + t) * N1 + C_GB + h * 256 + 8 * ch); }
    __syncthreads();
#pragma unroll
    for (int i = 0; i < 4; ++i) { const int idx = tid + NTHREADS * i, t = idx >> 5, ch = idx & 31;
        const u32x4 ov = *(const LAS u32x4*)(VS + t * 264 + 8 * ch);
        const u32x4 gv = gva[i];
        u32x4 o;
        o.x = pk2_hw(bflo(ov.x) * bflo(gv.x), bfhi(ov.x) * bfhi(gv.x)); o.y = pk2_hw(bflo(ov.y) * bflo(gv.y), bfhi(ov.y) * bfhi(gv.y));
        o.z = pk2_hw(bflo(ov.z) * bflo(gv.z), bfhi(ov.z) * bfhi(gv.z)); o.w = pk2_hw(bflo(ov.w) * bflo(gv.w), bfhi(ov.w) * bfhi(gv.w));
        *(u32x4*)(MIX + (row0 + t) * DM + 1024 + h * 256 + 8 * ch) = o; }
}

__device__ __forceinline__ float ret_log2_gamma(int h) { return log1pf(-exp2f(-5.f - (float)h)) * 1.4426950408889634f; }

__device__ __forceinline__ void ret_sample_item(const Frame& F, const Args& A, int it) {
    const int bd = it >> 3, h = it & 7, tid = F.tid, lane = F.lane, w = F.wave;
    const bf16_t* P1 = (const bf16_t*)(A.ws + WS_P1);
    bf16_t* RO = (bf16_t*)(A.ws + WS_RO);
    LAS float* q = (LAS float*)F.lds;
    LAS float* k = q + 1024;
    LAS float* vv = k + 1024;
    LAS float* Am = vv + 2048;
    LAS float* red = Am + 16;
    LAS float* OACC = red + 16;
    const size_t rowb = (size_t)TP + bd * 4;
    const float l2g = ret_log2_gamma(h);
    { const int d = tid & 255, t0 = (tid >> 8) * 2;
#pragma unroll
      for (int tt = 0; tt < 2; ++tt) { const int t = t0 + tt; q[t * 256 + d] = bf2f(P1[(rowb + t) * N3 + C_Q + h * 256 + d]); k[t * 256 + d] = bf2f(P1[(rowb + t) * N3 + C_K + h * 256 + d]); } }
#pragma unroll
    for (int t = 0; t < 4; ++t) vv[t * 512 + tid] = bf2f(P1[(rowb + t) * N3 + C_V + h * 512 + tid]);
    __syncthreads();
    { const int pair = tid >> 5, sub = tid & 31, t = pair >> 2, s = pair & 3; float p = 0.f;
#pragma unroll
      for (int i = 0; i < 8; ++i) p += q[t * 256 + sub + 32 * i] * k[s * 256 + sub + 32 * i];
      p += __shfl_xor(p, 1); p += __shfl_xor(p, 2); p += __shfl_xor(p, 4); p += __shfl_xor(p, 8); p += __shfl_xor(p, 16);
      if (sub == 0) Am[pair] = (s <= t) ? p * exp2f(l2g * (float)(t - s)) : 0.f; }
    { const int e4 = tid & 127, dg = tid >> 7;
      const float* S0 = A.in[I_SR] + ((size_t)(bd * 8 + h) * 256 + dg * 64) * 512 + 4 * e4;
      float* SN = A.out + O_RS + ((size_t)(bd * 8 + h) * 256 + dg * 64) * 512 + 4 * e4;
      f32x4 vr[4];
      const float kdsc[4] = {exp2f(l2g * 3.f), exp2f(l2g * 2.f), exp2f(l2g), 1.f};
#pragma unroll
      for (int t = 0; t < 4; ++t) vr[t] = *(const LAS f32x4*)(vv + t * 512 + 4 * e4) * kdsc[t];
      const float g4 = exp2f(l2g * 4.f);
      f32x4 oa[4];
#pragma unroll
      for (int t = 0; t < 4; ++t) oa[t] = (f32x4){0.f, 0.f, 0.f, 0.f};
#pragma unroll 1
      for (int i0 = 0; i0 < 64; i0 += 32) {
          f32x4 s0[32];
#pragma unroll
          for (int j = 0; j < 32; ++j) s0[j] = __builtin_nontemporal_load((const f32x4*)(S0 + (size_t)(i0 + j) * 512));
#pragma unroll
          for (int j = 0; j < 32; ++j) { const int d = dg * 64 + i0 + j;
              f32x4 sn = s0[j] * g4;
#pragma unroll
              for (int t = 0; t < 4; ++t) { sn += vr[t] * k[t * 256 + d]; oa[t] += s0[j] * q[t * 256 + d]; }
              __builtin_nontemporal_store(sn, (f32x4*)(SN + (size_t)(i0 + j) * 512)); } }
#pragma unroll
      for (int t = 0; t < 4; ++t) *(LAS f32x4*)(OACC + (dg * 4 + t) * 512 + 4 * e4) = oa[t]; }
    __syncthreads();
    { const int e = tid; float o[4];
#pragma unroll
      for (int t = 0; t < 4; ++t) { float s = 0.f;
#pragma unroll
          for (int dgi = 0; dgi < 4; ++dgi) s += OACC[(dgi * 4 + t) * 512 + e];
          s *= exp2f(l2g * (float)(t + 1));
#pragma unroll
          for (int s2 = 0; s2 < 4; ++s2) s += Am[t * 4 + s2] * vv[s2 * 512 + e];
          o[t] = s; }
      const float gg = A.in[I_RTG][e];
      bf16_t gsr[4];
#pragma unroll
      for (int t = 0; t < 4; ++t) gsr[t] = P1[(rowb + t) * N3 + C_G + h * 512 + e];
      float ssq[4];
#pragma unroll
      for (int t = 0; t < 4; ++t) ssq[t] = wave_sum(o[t] * o[t]);
      __syncthreads();
      if (lane == 0) {
#pragma unroll
          for (int t = 0; t < 4; ++t) OACC[w * 4 + t] = ssq[t]; }
      __syncthreads();
#pragma unroll
      for (int t = 0; t < 4; ++t) { float qsum = 0.f;
#pragma unroll
          for (int ww = 0; ww < 8; ++ww) qsum += OACC[ww * 4 + t];
          const float rr = rsqrtf(qsum * (1.f / 512.f) + EPS);
          const float gs = bf2f(gsr[t]);
          RO[(rowb + t) * KO1 + h * 512 + e] = (bf16_t)f2bf_hw(o[t] * rr * gg * gs); } }
}

__device__ __forceinline__ void ret_state_item(const Frame& F, const Args& A, int it) {
    const int bh = it >> 3, eb = (it >> 1) & 3, db = it & 1, b = bh >> 3, h = bh & 7;
    const int tid = F.tid, lane = F.lane, w = F.wave, g = lane >> 4, i15 = lane & 15;
    const bf16_t* P1 = (const bf16_t*)(A.ws + WS_P1);
    bf16_t* SPR = (bf16_t*)(A.ws + WS_SPR);
    LAS bf16_t* KD = (LAS bf16_t*)F.lds;
    LAS bf16_t* VS = KD + 128 * 136;
    LAS bf16_t* ST = VS + 128 * 136;
    const float l2g = ret_log2_gamma(h);
    const float g128 = exp2f(l2g * 128.f);
    const int we = w >> 2, wd = w & 3;
    const int r0 = tid >> 4, ch = tid & 15;
    float ksc[4];
#pragma unroll
    for (int i = 0; i < 4; ++i) ksc[i] = exp2f(l2g * (float)(127 - (r0 + 32 * i)));
    f32x4 S[4][2];
#pragma unroll
    for (int m = 0; m < 4; ++m) { S[m][0] = (f32x4){0.f, 0.f, 0.f, 0.f}; S[m][1] = S[m][0]; }
    const bf16_t* kp = P1 + ((size_t)b * SEQ + r0) * N3 + C_K + h * 256 + db * 128 + 8 * ch;
    const bf16_t* vp = P1 + ((size_t)b * SEQ + r0) * N3 + C_V + h * 512 + eb * 128 + 8 * ch;
    u32x4 kr[4], vr[4];
#pragma unroll
    for (int i = 0; i < 4; ++i) { kr[i] = *(const u32x4*)(kp + (size_t)(32 * i) * N3); vr[i] = *(const u32x4*)(vp + (size_t)(32 * i) * N3); }
    for (int c = 0; c < 32; ++c) {
#pragma unroll
        for (int i = 0; i < 4; ++i) { const float sc = ksc[i]; u32x4 o;
            o.x = pk2_hw(bflo(kr[i].x) * sc, bfhi(kr[i].x) * sc); o.y = pk2_hw(bflo(kr[i].y) * sc, bfhi(kr[i].y) * sc); o.z = pk2_hw(bflo(kr[i].z) * sc, bfhi(kr[i].z) * sc); o.w = pk2_hw(bflo(kr[i].w) * sc, bfhi(kr[i].w) * sc);
            *(LAS u32x4*)(KD + (r0 + 32 * i) * 136 + 8 * ch) = o; *(LAS u32x4*)(VS + (r0 + 32 * i) * 136 + 8 * ch) = vr[i]; }
        if (c + 1 < 32) { kp += (size_t)128 * N3; vp += (size_t)128 * N3;
#pragma unroll
            for (int i = 0; i < 4; ++i) { kr[i] = *(const u32x4*)(kp + (size_t)(32 * i) * N3); vr[i] = *(const u32x4*)(vp + (size_t)(32 * i) * N3); } }
#pragma unroll
        for (int m = 0; m < 4; ++m)
#pragma unroll
            for (int n = 0; n < 2; ++n)
#pragma unroll
                for (int r = 0; r < 4; ++r) ST[(64 * we + 16 * m + 4 * g + r) * 136 + 32 * wd + 16 * n + i15] = (bf16_t)f2bf_hw(S[m][n][r]);
        __syncthreads();
        { bf16_t* dst = SPR + ((size_t)(bh * 32 + c) * 512 + eb * 128 + r0) * 256 + db * 128 + 8 * ch;
#pragma unroll
          for (int i = 0; i < 4; ++i) *(u32x4*)(dst + (size_t)(32 * i) * 256) = *(const LAS u32x4*)(ST + (r0 + 32 * i) * 136 + 8 * ch); }
        { f32x4 nw[4][2];
#pragma unroll
          for (int m = 0; m < 4; ++m) { nw[m][0] = (f32x4){0.f, 0.f, 0.f, 0.f}; nw[m][1] = nw[m][0]; }
#pragma unroll
          for (int ks = 0; ks < 4; ++ks) { const bf16x8 b0 = frag_tr(KD, 136, 32 * wd, 32 * ks, lane), b1 = frag_tr(KD, 136, 32 * wd + 16, 32 * ks, lane);
#pragma unroll
              for (int m = 0; m < 4; ++m) { const bf16x8 a = frag_tr(VS, 136, 64 * we + 16 * m, 32 * ks, lane); nw[m][0] = MFMA16(a, b0, nw[m][0]); nw[m][1] = MFMA16(a, b1, nw[m][1]); } }
#pragma unroll
          for (int m = 0; m < 4; ++m) { S[m][0] = S[m][0] * g128 + nw[m][0]; S[m][1] = S[m][1] * g128 + nw[m][1]; } }
        __syncthreads();
    }
    { float* rp = A.out + O_RP + ((size_t)bh * 256 + db * 128 + 32 * wd + i15) * 512 + eb * 128 + 64 * we + 4 * g;
#pragma unroll
      for (int m = 0; m < 4; ++m) { *(f32x4*)(rp + 16 * m) = S[m][0]; *(f32x4*)(rp + (size_t)16 * 512 + 16 * m) = S[m][1]; } }
}

__device__ __forceinline__ void ret_out_item(const Frame& F, const Args& A, int it) {
    const int bh = it >> 5, c = it & 31, b = bh >> 3, h = bh & 7;
    const int tid = F.tid, lane = F.lane, w = F.wave, g = lane >> 4, i15 = lane & 15;
    const bf16_t* P1 = (const bf16_t*)(A.ws + WS_P1);
    const bf16_t* SPR = (const bf16_t*)(A.ws + WS_SPR);
    bf16_t* RO = (bf16_t*)(A.ws + WS_RO);
    LAS bf16_t* KQ = (LAS bf16_t*)F.lds;
    LAS bf16_t* AM = KQ + 128 * 264;
    LAS bf16_t* VS = AM + 128 * 136;
    LAS float* RS = (LAS float*)(VS + 128 * 136);
    const float l2g = ret_log2_gamma(h);
    const size_t row0 = (size_t)b * SEQ + c * 128;
    { u32x4 kr[8];
      int tq = tid; asm volatile("" : "+v"(tq));
      const bf16_t* kp = P1 + (row0 + (tq >> 5)) * N3 + C_K + h * 256 + 8 * (tq & 31);
#pragma unroll
      for (int i = 0; i < 8; ++i) kr[i] = *(const u32x4*)(kp + (size_t)i * 16 * N3);
#pragma unroll
      for (int i = 0; i < 8; ++i) { const int idx = tid + NTHREADS * i, r = idx >> 5, ch = idx & 31; *(LAS u32x4*)(KQ + r * 264 + 8 * ch) = kr[i]; } }
    bf16x8 aq[8];
    { const bf16_t* qsrc = P1 + (row0 + 16 * w + i15) * N3 + C_Q + h * 256 + 8 * g;
#pragma unroll
      for (int ks = 0; ks < 8; ++ks) aq[ks] = *(const bf16x8*)(qsrc + 32 * ks); }
    __syncthreads();
#pragma unroll 1
    for (int st = 0; st < 8; ++st) {
        f32x4 sa = (f32x4){0.f, 0.f, 0.f, 0.f};
        if (st <= w) {
#pragma unroll
            for (int ks = 0; ks < 8; ++ks) sa = MFMA16(aq[ks], frag_nat(KQ, 264, 16 * st, 32 * ks, lane), sa);
        }
#pragma unroll
        for (int r = 0; r < 4; ++r) { const int t = 16 * w + 4 * g + r, s2 = 16 * st + i15;
            AM[t * 136 + s2] = (bf16_t)f2bf_hw(s2 <= t ? sa[r] * exp2f(l2g * (float)(t - s2)) : 0.f); }
    }
    __syncthreads();
    { u32x4 qr[8];
      int tq = tid; asm volatile("" : "+v"(tq));
      const bf16_t* qp = P1 + (row0 + (tq >> 5)) * N3 + C_Q + h * 256 + 8 * (tq & 31);
#pragma unroll
      for (int i = 0; i < 8; ++i) qr[i] = *(const u32x4*)(qp + (size_t)i * 16 * N3);
#pragma unroll
      for (int i = 0; i < 8; ++i) { const int idx = tid + NTHREADS * i, r = idx >> 5, ch = idx & 31; const float qs = exp2f(l2g * (float)(r + 1)); const u32x4 x = qr[i]; u32x4 o;
          o.x = pk2_hw(bflo(x.x) * qs, bfhi(x.x) * qs); o.y = pk2_hw(bflo(x.y) * qs, bfhi(x.y) * qs); o.z = pk2_hw(bflo(x.z) * qs, bfhi(x.z) * qs); o.w = pk2_hw(bflo(x.w) * qs, bfhi(x.w) * qs);
          *(LAS u32x4*)(KQ + r * 264 + 8 * ch) = o; } }
    const int wt = w >> 2, we = w & 3;
    f32x4 acc[4][4][2];
#pragma unroll
    for (int eq = 0; eq < 4; ++eq)
#pragma unroll
        for (int m = 0; m < 4; ++m) { acc[eq][m][0] = (f32x4){0.f, 0.f, 0.f, 0.f}; acc[eq][m][1] = acc[eq][m][0]; }
    u32x4 vpre[4];
    { int tq = tid; asm volatile("" : "+v"(tq));
      const bf16_t* vp = P1 + (row0 + (tq >> 4)) * N3 + C_V + h * 512 + 8 * (tq & 15);
#pragma unroll
      for (int i = 0; i < 4; ++i) vpre[i] = *(const u32x4*)(vp + (size_t)i * 32 * N3); }
#pragma unroll
    for (int eq = 0; eq < 4; ++eq) {
#pragma unroll
        for (int i = 0; i < 4; ++i) { const int idx = tid + NTHREADS * i, r = idx >> 4, ch = idx & 15; *(LAS u32x4*)(VS + r * 136 + 8 * ch) = vpre[i]; }
        bf16x8 sb[8];
        int ln = lane; asm volatile("" : "+v"(ln));
        const bf16_t* sp = SPR + ((size_t)(bh * 32 + c) * 512 + eq * 128 + 32 * we + (ln & 15)) * 256 + 8 * (ln >> 4);
#pragma unroll
        for (int j = 0; j < 4; ++j) { sb[2 * j] = *(const bf16x8*)(sp + 32 * j); sb[2 * j + 1] = *(const bf16x8*)(sp + 16 * 256 + 32 * j); }
        if (eq < 3) { int tq = tid; asm volatile("" : "+v"(tq));
            const bf16_t* vp = P1 + (row0 + (tq >> 4)) * N3 + C_V + h * 512 + (eq + 1) * 128 + 8 * (tq & 15);
#pragma unroll
            for (int i = 0; i < 4; ++i) vpre[i] = *(const u32x4*)(vp + (size_t)i * 32 * N3); }
        __syncthreads();
#pragma unroll 1
        for (int ks = 0; ks < 2 * (wt + 1); ++ks) { const bf16x8 b0 = frag_tr(VS, 136, 32 * we, 32 * ks, lane), b1 = frag_tr(VS, 136, 32 * we + 16, 32 * ks, lane);
#pragma unroll
            for (int m = 0; m < 4; ++m) { if (32 * ks <= 64 * wt + 16 * m + 15) { const bf16x8 a = frag_nat(AM, 136, 64 * wt + 16 * m, 32 * ks, lane);
                acc[eq][m][0] = MFMA16(a, b0, acc[eq][m][0]); acc[eq][m][1] = MFMA16(a, b1, acc[eq][m][1]); } } }
#pragma unroll 1
        for (int ks = 0; ks < 8; ++ks) {
#pragma unroll
            for (int m = 0; m < 4; ++m) { const bf16x8 a = frag_nat(KQ, 264, 64 * wt + 16 * m, 32 * ks, lane);
                acc[eq][m][0] = MFMA16(a, sb[0], acc[eq][m][0]); acc[eq][m][1] = MFMA16(a, sb[1], acc[eq][m][1]); }
#pragma unroll
            for (int j = 0; j < 6; ++j) sb[j] = sb[j + 2];
            if (ks + 4 < 8) { sb[6] = *(const bf16x8*)(sp + 32 * (ks + 4)); sb[7] = *(const bf16x8*)(sp + 16 * 256 + 32 * (ks + 4)); }
        }
        __syncthreads();
    }
#pragma unroll
    for (int m = 0; m < 4; ++m)
#pragma unroll
        for (int r = 0; r < 4; ++r) { float ss = 0.f;
#pragma unroll
            for (int eq = 0; eq < 4; ++eq) ss += acc[eq][m][0][r] * acc[eq][m][0][r] + acc[eq][m][1][r] * acc[eq][m][1][r];
            ss = red16_sum(ss); if (i15 == 0) RS[we * 128 + 64 * wt + 16 * m + 4 * g + r] = ss; asm volatile("" ::: "memory"); }
    __syncthreads();
    LAS bf16_t* OS = (LAS bf16_t*)F.lds;
    { float rg[4][2];
#pragma unroll
      for (int eq = 0; eq < 4; ++eq) { rg[eq][0] = A.in[I_RTG][eq * 128 + 32 * we + i15]; rg[eq][1] = A.in[I_RTG][eq * 128 + 32 * we + 16 + i15]; }
#pragma unroll
      for (int m = 0; m < 4; ++m)
#pragma unroll
          for (int r = 0; r < 4; ++r) { const int t = 64 * wt + 16 * m + 4 * g + r;
              const float rr = rsqrtf((RS[t] + RS[128 + t] + RS[256 + t] + RS[384 + t]) * (1.f / 512.f) + EPS);
#pragma unroll
              for (int eq = 0; eq < 4; ++eq) { OS[t * 520 + eq * 128 + 32 * we + i15] = (bf16_t)f2bf_hw(acc[eq][m][0][r] * rr * rg[eq][0]); OS[t * 520 + eq * 128 + 32 * we + 16 + i15] = (bf16_t)f2bf_hw(acc[eq][m][1][r] * rr * rg[eq][1]); }
              asm volatile("" ::: "memory"); } }
    int tq2 = tid; asm volatile("" : "+v"(tq2));
    u32x4 gva[16];
#pragma unroll
    for (int i = 0; i < 16; ++i) { const int idx = tq2 + NTHREADS * i, t = idx >> 6, ch = idx & 63; gva[i] = *(const u32x4*)(P1 + (row0 + t) * N3 + C_G + h * 512 + 8 * ch); }
    __syncthreads();
#pragma unroll
    for (int i = 0; i < 16; ++i) { const int idx = tq2 + NTHREADS * i, t = idx >> 6, ch = idx & 63;
        const u32x4 ov = *(const LAS u32x4*)(OS + t * 520 + 8 * ch);
        const u32x4 gv = gva[i];
        u32x4 o;
        o.x = pk2_hw(bflo(ov.x) * bflo(gv.x), bfhi(ov.x) * bfhi(gv.x)); o.y = pk2_hw(bflo(ov.y) * bflo(gv.y), bfhi(ov.y) * bfhi(gv.y));
        o.z = pk2_hw(bflo(ov.z) * bflo(gv.z), bfhi(ov.z) * bfhi(gv.z)); o.w = pk2_hw(bflo(ov.w) * bflo(gv.w), bfhi(ov.w) * bfhi(gv.w));
        *(u32x4*)(RO + (row0 + t) * KO1 + h * 512 + 8 * ch) = o; }
}

#ifndef MK_N_LAUNCHES
#define MK_N_LAUNCHES 1
#endif
constexpr int NPH = 13;
constexpr int RET_S9 = 512;
constexpr int RET_S10 = 1024;
#ifndef PG8_SP2
#define PG8_SP2 true
#endif
#ifndef PG8_ALIGN
#define PG8_ALIGN true
#endif

__global__ void __launch_bounds__(NTHREADS, 2) mega_fwd(Args args) {
    extern __shared__ __attribute__((aligned(16))) unsigned char lds_raw[];
    Frame F;
    F.lds = (LAS unsigned char*)lds_raw + LDS_SCR;
    F.MISC = (volatile LAS unsigned*)((LAS unsigned char*)lds_raw + LDS_MISC);
    F.tid = threadIdx.x; F.lane = F.tid & 63; F.wave = __builtin_amdgcn_readfirstlane(F.tid >> 6);
    F.G = gridDim.x;
    if (F.tid < 64) F.MISC[F.tid] = 0u;
    __syncthreads();
    unsigned* ctl = (unsigned*)(args.ws + WS_CTL);
    XcdBarrier bar; bar.bar = ctl + CW_BAR; bar.x = 0; bar.st = nullptr;
    const int lo = args.ph_lo, hi = args.ph_hi & 255, qmask = (args.ph_hi >> 8) ? (args.ph_hi >> 8) : 255;
    if (hi - lo > 1) bar = xcd_barrier_post(ctl + CW_BAR, F.MISC + 8);
#ifndef PH_MASK
#define PH_MASK 0x1fff
#endif
#define IN(k) (((PH_MASK >> (k)) & 1) && lo <= (k) && (k) < hi)
#define SEAM(k) do { if (IN(k) && IN((k) + 1)) xcd_barrier(bar); } while (0)
    unsigned char* ws = args.ws;

    if (IN(0)) { p1_mods(F, args); __syncthreads(); p0_prologue(F, args); }
    SEAM(0);
    if (IN(1)) { mods_reduce(F, args); } SEAM(1);
    if (IN(2)) { norm_phase(F, args, 0); } SEAM(2);
    if (IN(3)) {
        pg8::Gemm g{(const bf16_t*)(ws + WS_H), (const bf16_t*)(ws + WS_WT1), MROWS, N1P, DM}; pg8::StaticOrder S; S.init(MROWS, N1P, F.G, (int)blockIdx.x);
        EpiP0 E{(bf16_t*)(ws + WS_P0), (float*)(ws + WS_LR)};
        pg8::gemm_phase<EpiP0, pg8::StaticOrder, PG8_ALIGN, PG8_SP2>(F.lds, g, S, E);
    } SEAM(3);
    if (IN(4)) {
        if ((qmask & 1) && (int)blockIdx.x < 64 && F.G >= 64) gla_state_item(F, args, ((int)blockIdx.x & 7) * 8 + ((int)blockIdx.x >> 3));
        else if ((qmask & 1) && F.G < 64) for (int it = blockIdx.x; it < 64; it += F.G) { gla_state_item(F, args, it); __syncthreads(); }
        if (qmask & 2) for (;;) { const int it = next_item(F, ctl + CW_Q0 + 128); if (it >= 128) break; swa_prompt_item(F, args, it); }
        if (qmask & 4) for (;;) { const int it = next_item(F, ctl + CW_Q0 + 192); if (it >= 256) break; swa_sample_item(F, args, it); }
        if (qmask & 8) for (;;) { const int it = next_item(F, ctl + CW_Q0 + 256); if (it >= 512) break; gla_sample_item(F, args, it); }
        if (qmask & 16) tr_queue(F, args, ctl + CW_Q0 + 448);
    } SEAM(4);
    if (IN(5)) {
        for (int it = blockIdx.x; it < 512; it += F.G) { gla_out_item(F, args, it); __syncthreads(); }
    } SEAM(5);
    if (IN(6)) {
        pg8::Gemm g{(const bf16_t*)(ws + WS_MIX), (const bf16_t*)(ws + WS_WT2), TP, DM, DM}; pg8::StaticOrder S; S.init(TP, DM, F.G, (int)blockIdx.x);
        EpiY1 E{args.in[I_XP], (const float*)(ws + WS_MOD0), (bf16_t*)(ws + WS_Y1)};
        pg8::gemm_phase<EpiY1, pg8::StaticOrder, PG8_ALIGN, PG8_SP2>(F.lds, g, S, E);
        mini_gemm_sample<true>(F, (const bf16_t*)(ws + WS_MIX) + (size_t)TP * DM, (const bf16_t*)(ws + WS_WT2), DM, args.in[I_XS], (const float*)(ws + WS_MOD0), ws + WS_Y1);
    } SEAM(6);
    if (IN(7)) { norm_phase(F, args, 1); } SEAM(7);
    if (IN(8)) {
        pg8::Gemm g{(const bf16_t*)(ws + WS_H), (const bf16_t*)(ws + WS_WT3), MROWS, N3, DM}; pg8::StaticOrder S; S.init(MROWS, N3, F.G, (int)blockIdx.x);
        EpiP1 E{(bf16_t*)(ws + WS_P1), (const f32x2*)(ws + WS_ROT)};
        pg8::gemm_phase<EpiP1, pg8::StaticOrder, PG8_ALIGN, PG8_SP2>(F.lds, g, S, E);
        { const int nfull = (MROWS / 256) * (N3 / 256) - 6 * F.G;
          if (nfull >= 0 && nfull < F.G && (int)blockIdx.x >= nfull) wt4_transposes(F, args, nfull);
          else if (nfull < 0 || nfull >= F.G) wt4_transposes(F, args, 0); }
    } SEAM(8);
    if (IN(9)) {
        if ((qmask & 1) && (int)blockIdx.x < 128 && F.G >= 128) { const int x = (int)blockIdx.x & 7, j = (int)blockIdx.x >> 3; ret_state_item(F, args, (2 * x + (j >> 3)) * 8 + (j & 7)); }
        else if ((qmask & 1) && F.G < 128) for (int it = blockIdx.x; it < 128; it += F.G) { ret_state_item(F, args, it); __syncthreads(); }
        if (qmask & 2) for (;;) { const int it = next_item(F, ctl + CW_Q0 + 384); if (it >= RET_S9) break; ret_sample_item(F, args, it); }
    } SEAM(9);
    if (IN(10)) {
        const bool stream_first = (((int)blockIdx.x >> 3) & 1) == 0;
        if (stream_first) { for (int it = RET_S9 + (int)blockIdx.x; it < RET_S10; it += F.G) { ret_sample_item(F, args, it); __syncthreads(); } }
        for (int it = blockIdx.x; it < 512; it += F.G) { ret_out_item(F, args, it); __syncthreads(); }
        if (!stream_first) { for (int it = RET_S9 + (int)blockIdx.x; it < RET_S10; it += F.G) { ret_sample_item(F, args, it); __syncthreads(); } }
    } SEAM(10);
    if (IN(11)) {
        const bool tile_first = (((int)blockIdx.x >> 3) & 1) == 0;
        if (!tile_first) { for (int it = RET_S10 + (int)blockIdx.x; it < 1024; it += F.G) { __syncthreads(); ret_sample_item(F, args, it); } __syncthreads(); }
        { pg8::Gemm g{(const bf16_t*)(ws + WS_RO), (const bf16_t*)(ws + WS_WT4), TP, DM, KO1}; pg8::StaticOrder S; S.init(TP, DM, F.G, (int)blockIdx.x);
          EpiOut E{(const bf16_t*)(ws + WS_Y1), (const float*)(ws + WS_MOD1), args.out + O_Y};
          pg8::gemm_phase<EpiOut, pg8::StaticOrder, PG8_ALIGN, PG8_SP2>(F.lds, g, S, E); }
        if (tile_first) { for (int it = RET_S10 + (int)blockIdx.x; it < 1024; it += F.G) { __syncthreads(); ret_sample_item(F, args, it); } __syncthreads(); }
        static_assert(RET_S10 == 1024, "the sample rows' GEMM4 rides in phase 11 only if no sample-state item is left for this phase");
        __syncthreads();
        mini_gemm_sample<false>(F, (const bf16_t*)(ws + WS_RO) + (size_t)TP * KO1, (const bf16_t*)(ws + WS_WT4), KO1, (const bf16_t*)(ws + WS_Y1) + (size_t)TP * DM, (const float*)(ws + WS_MOD1), args.out + O_Y);
    }
    if (IN(12)) { }
#undef IN
#undef SEAM
}

extern "C" void kernel_launch(void* const* d_in, const int* in_sizes, int n_in, void* d_out, int out_size, void* d_ws, size_t ws_size, hipStream_t stream) {
    static int grid = 0;
    if (grid == 0) {
        if (n_in != N_IN || (size_t)out_size != O_END || ws_size < WS_END) { fprintf(stderr, "kernel_launch: unexpected shapes: n_in %d out %d ws %zu\n", n_in, out_size, ws_size); grid = -1; return; }
        int dev = 0, cus = 0, per_cu = 0;
        if (hipGetDevice(&dev) != hipSuccess || hipDeviceGetAttribute(&cus, hipDeviceAttributeMultiprocessorCount, dev) != hipSuccess) { grid = -1; return; }
        if (hipFuncSetAttribute((const void*)mega_fwd, hipFuncAttributeMaxDynamicSharedMemorySize, LDS_BYTES) != hipSuccess) { fprintf(stderr, "kernel_launch: hipFuncSetAttribute failed\n"); grid = -1; return; }
        if (hipOccupancyMaxActiveBlocksPerMultiprocessor(&per_cu, (const void*)mega_fwd, NTHREADS, LDS_BYTES) != hipSuccess || per_cu < 1) { fprintf(stderr, "kernel_launch: occupancy query says %d\n", per_cu); per_cu = 1; }
        (void)hipGetLastError();
        grid = cus;
    }
    if (grid < 0) return;
    (void)hipMemsetAsync((char*)d_ws + WS_CTL, 0, CTL_ZERO_BYTES, stream);
    Args a{};
    for (int i = 0; i < N_IN; ++i) a.in[i] = (const float*)d_in[i];
    a.out = (float*)d_out; a.ws = (unsigned char*)d_ws;
#if MK_N_LAUNCHES == 1
    a.ph_lo = 0; a.ph_hi = NPH;
    { void* kargs[] = {&a};
      hipError_t e = hipLaunchCooperativeKernel((const void*)mega_fwd, dim3(grid), dim3(NTHREADS), kargs, LDS_BYTES, stream);
      if (e != hipSuccess) fprintf(stderr, "kernel_launch: cooperative launch failed: %s (grid %d)\n", hipGetErrorString(e), grid); }
#ifdef PROBE_PHASE
#ifndef PROBE_QMASK
#define PROBE_QMASK 0
#endif
    (void)hipMemsetAsync((char*)d_ws + WS_CTL, 0, CTL_ZERO_BYTES, stream);
    a.ph_lo = PROBE_PHASE; a.ph_hi = (PROBE_PHASE + 1) | (PROBE_QMASK << 8);
    hipLaunchKernelGGL(mega_fwd, dim3(grid), dim3(NTHREADS), LDS_BYTES, stream, a);
#endif
#else
    for (int p = 0; p < NPH; ++p) { a.ph_lo = p; a.ph_hi = p + 1;
        hipLaunchKernelGGL(mega_fwd, dim3(grid), dim3(NTHREADS), LDS_BYTES, stream, a);
        hipError_t e = hipPeekAtLastError(); if (e != hipSuccess) { fprintf(stderr, "kernel_launch: launch %d failed: %s\n", p, hipGetErrorName(e)); break; } }
#endif
}
```
